# Optimizing an MI355X kernel written in HIP

```python
import math
import jax
import jax.numpy as jnp
from jax import lax
import numpy as np

D_MODEL = 1024
BATCH = 4
SEQ = 8192
DEPTH = 1

D_RNN = D_MODEL
RNN_BLOCKS = 8
RNN_BW = D_RNN // RNN_BLOCKS
CONV_W = 4
LRU_C = 8.0
N_HEADS = 8
HEAD_DIM = 128
D_ATTN = N_HEADS * HEAD_DIM
IDX_HEADS = 16
IDX_DIM = 64
TOPK_MAX = 256
Q_BLOCK = 128
N_BUCKETS = 32
MAX_DIST = 128
N_EXPERTS = 64
TOP_K = 8
N_GROUPS = 8
TOPK_GROUPS = 4
D_EXPERT = 256
D_SHARED = 256
ROUTED_SCALE = 2.5
EXPERT_CHUNK = 128
IN_SIZES = (D_RNN, D_RNN, D_ATTN, D_ATTN, D_ATTN, IDX_HEADS * IDX_DIM, IDX_DIM, IDX_HEADS, D_MODEL, D_MODEL)
W_IN = sum(IN_SIZES)
N_MOD = 6
EPS = 1e-6

kernel_name = 'hybrid_rglru_dsa_moe_block'


def rms_norm(x, g):
    xf = x.astype(jnp.float32)
    xf = xf * lax.rsqrt(jnp.mean(xf * xf, axis=-1, keepdims=True) + EPS)
    return (xf * g.astype(jnp.float32)).astype(x.dtype)


def t5_bucket(dist):
    max_exact = N_BUCKETS // 2
    d = jnp.maximum(dist, 0)
    df = jnp.maximum(d, 1).astype(jnp.float32)
    large = max_exact + (jnp.log(df / max_exact) / math.log(MAX_DIST / max_exact)
                         * (N_BUCKETS - max_exact)).astype(jnp.int32)
    large = jnp.minimum(large, N_BUCKETS - 1)
    return jnp.where(d < max_exact, d, large)


def causal_depthwise_conv(u, w, b):
    out = lax.conv_general_dilated(
        u, w[:, None, :].astype(u.dtype), window_strides=(1,), padding=((CONV_W - 1, 0),),
        dimension_numbers=('NWC', 'WIO', 'NWC'), feature_group_count=u.shape[-1])
    return out + b


def rg_lru(xc, w_a, b_a, w_x, b_x, lam):
    B, S, _ = xc.shape
    xb = xc.reshape(B, S, RNN_BLOCKS, RNN_BW)
    r = jax.nn.sigmoid(jnp.einsum('bsnd,nde->bsne', xb, w_a) + b_a).reshape(B, S, D_RNN)
    i = jax.nn.sigmoid(jnp.einsum('bsnd,nde->bsne', xb, w_x) + b_x).reshape(B, S, D_RNN)
    log_a = -LRU_C * r.astype(jnp.float32) * jax.nn.softplus(-lam.astype(jnp.float32))
    a = jnp.exp(log_a)
    b = jnp.sqrt(-jnp.expm1(2.0 * log_a)) * (i * xc).astype(jnp.float32)

    def combine(lhs, rhs):
        a1, b1 = lhs
        a2, b2 = rhs
        return a1 * a2, a2 * b1 + b2

    _, h = lax.associative_scan(combine, (a, b), axis=1)
    return h.astype(xc.dtype)


def dsa_attention(q, k, v, q_idx, k_idx, w_idx, rel_bias):
    B, S, H, Dh = q.shape
    n_blocks = S // Q_BLOCK
    topk = min(TOPK_MAX, S // 4)
    key_pos = jnp.arange(S, dtype=jnp.int32)
    take = jax.vmap(lambda arr, idx: arr[idx])

    def block(j):
        t0 = j * Q_BLOCK
        qpos = t0 + jnp.arange(Q_BLOCK, dtype=jnp.int32)
        qb = lax.dynamic_slice_in_dim(q, t0, Q_BLOCK, axis=1)
        qi = lax.dynamic_slice_in_dim(q_idx, t0, Q_BLOCK, axis=1)
        wi = lax.dynamic_slice_in_dim(w_idx, t0, Q_BLOCK, axis=1)
        dots = jnp.einsum('bqhd,bsd->bqhs', qi, k_idx) * (IDX_DIM ** -0.5)
        score = jnp.einsum('bqhs,bqh->bqs', jax.nn.relu(dots), wi).astype(jnp.float32)
        causal = key_pos[None, :] <= qpos[:, None]
        score = jnp.where(causal[None], score, -jnp.inf)
        _, sel = lax.top_k(score, topk)
        valid = sel <= qpos[None, :, None]
        k_sel = take(k, sel)
        v_sel = take(v, sel)
        logits = jnp.einsum('bqhd,bqkhd->bhqk', qb, k_sel).astype(jnp.float32) * (Dh ** -0.5)
        bias = rel_bias[t5_bucket(qpos[None, :, None] - sel)]
        logits = logits + jnp.transpose(bias, (0, 3, 1, 2)).astype(jnp.float32)
        logits = jnp.where(valid[:, None], logits, -jnp.inf)
        p = jax.nn.softmax(logits, axis=-1).astype(v.dtype)
        return jnp.einsum('bhqk,bqkhd->bqhd', p, v_sel)

    out = lax.map(block, jnp.arange(n_blocks, dtype=jnp.int32))
    return jnp.transpose(out, (1, 0, 2, 3, 4)).reshape(B, S, H * Dh)


def token_mixer(h, w_in, conv_w, conv_b, w_rg_a, b_rg_a, w_rg_x, b_rg_x, lru_lambda,
                w_br_rnn, w_br_attn, w_out, rel_bias):
    B, S, _ = h.shape
    z = h @ w_in
    splits = [int(o) for o in np.cumsum(IN_SIZES)[:-1]]
    u_rnn, u_gate, q, k, v, qi, ki, wi, gl_rnn, gl_attn = jnp.split(z, splits, axis=-1)
    xc = causal_depthwise_conv(u_rnn, conv_w, conv_b)
    y_rnn = rg_lru(xc, w_rg_a, b_rg_a, w_rg_x, b_rg_x, lru_lambda) * jax.nn.gelu(u_gate)
    y_attn = dsa_attention(
        q.reshape(B, S, N_HEADS, HEAD_DIM), k.reshape(B, S, N_HEADS, HEAD_DIM),
        v.reshape(B, S, N_HEADS, HEAD_DIM), qi.reshape(B, S, IDX_HEADS, IDX_DIM), ki,
        wi * (IDX_HEADS ** -0.5), rel_bias)
    merged = jax.nn.sigmoid(gl_rnn) * (y_rnn @ w_br_rnn) + jax.nn.sigmoid(gl_attn) * (y_attn @ w_br_attn)
    return merged @ w_out


def route(h, w_router, router_bias):
    N = h.shape[0]
    s = jax.nn.sigmoid((h @ w_router).astype(jnp.float32))
    s_sel = s + router_bias.astype(jnp.float32)
    grp = s_sel.reshape(N, N_GROUPS, N_EXPERTS // N_GROUPS)
    grp_score = lax.top_k(grp, 2)[0].sum(-1)
    _, top_g = lax.top_k(grp_score, TOPK_GROUPS)
    gmask = jax.nn.one_hot(top_g, N_GROUPS, dtype=jnp.float32).sum(1) > 0
    emask = jnp.repeat(gmask, N_EXPERTS // N_GROUPS, axis=1)
    _, sel = lax.top_k(jnp.where(emask, s_sel, -jnp.inf), TOP_K)
    w = jnp.take_along_axis(s, sel, axis=-1)
    w = w / jnp.sum(w, axis=-1, keepdims=True) * ROUTED_SCALE
    return sel, w


def routed_experts(h, sel, wts, w_gate, w_up, w_down):
    N, D = h.shape
    A = N * TOP_K
    flat_e = sel.reshape(A)
    flat_tok = jnp.arange(A, dtype=jnp.int32) // TOP_K
    flat_w = wts.reshape(A).astype(h.dtype)
    order = jnp.argsort(flat_e)
    sorted_e = flat_e[order]
    counts = jnp.bincount(flat_e, length=N_EXPERTS)
    padded = (counts + EXPERT_CHUNK - 1) // EXPERT_CHUNK * EXPERT_CHUNK
    start = jnp.cumsum(counts) - counts
    pad_end = jnp.cumsum(padded)
    pad_start = pad_end - padded
    dest = pad_start[sorted_e] + jnp.arange(A, dtype=jnp.int32) - start[sorted_e]
    n_chunks = -(-A // EXPERT_CHUNK) + N_EXPERTS
    P = n_chunks * EXPERT_CHUNK
    buf_tok = jnp.full((P,), N, jnp.int32).at[dest].set(flat_tok[order])
    buf_w = jnp.zeros((P,), h.dtype).at[dest].set(flat_w[order])
    chunk_start = jnp.arange(n_chunks, dtype=jnp.int32) * EXPERT_CHUNK
    chunk_e = jnp.minimum(jnp.searchsorted(pad_end, chunk_start, side='right'), N_EXPERTS - 1)
    h_pad = jnp.concatenate([h, jnp.zeros((1, D), h.dtype)], axis=0)

    def run(args):
        e, toks, w = args
        xs = h_pad[toks]
        y = (jax.nn.silu(xs @ w_gate[e]) * (xs @ w_up[e])) @ w_down[e]
        return y * w[:, None]

    ys = lax.map(run, (chunk_e, buf_tok.reshape(n_chunks, EXPERT_CHUNK),
                       buf_w.reshape(n_chunks, EXPERT_CHUNK)))
    return jax.ops.segment_sum(ys.reshape(P, D), buf_tok, num_segments=N + 1)[:N]


def moe_ffn(h, w_router, router_bias, w_exp_gate, w_exp_up, w_exp_down, w_sh_gate, w_sh_up, w_sh_down):
    sel, wts = route(h, w_router, router_bias)
    routed = routed_experts(h, sel, wts, w_exp_gate, w_exp_up, w_exp_down)
    shared = (jax.nn.silu(h @ w_sh_gate) * (h @ w_sh_up)) @ w_sh_down
    return routed + shared


def setup_inputs(seed: int = 0) -> dict:
    key = jax.random.key(seed)
    ks = jax.random.split(key, 25)
    s_d = D_MODEL ** -0.5

    def nrm(k, shape, scale):
        return scale * jax.random.normal(k, shape, jnp.float32)

    lru_u = jax.random.uniform(ks[12], (DEPTH, D_RNN), jnp.float32, minval=0.9, maxval=0.999)
    a0 = lru_u ** (1.0 / LRU_C)
    return {
        'x': nrm(ks[0], (BATCH, SEQ, D_MODEL), 1.0),
        'c': nrm(ks[1], (BATCH, D_MODEL), 1.0),
        'w_ada': nrm(ks[2], (DEPTH, D_MODEL, N_MOD * D_MODEL), 0.5 * s_d),
        'b_ada': nrm(ks[3], (DEPTH, N_MOD * D_MODEL), 0.02),
        'norm_gain': 1.0 + nrm(ks[4], (DEPTH, 4, D_MODEL), 0.02),
        'w_in': nrm(ks[5], (DEPTH, D_MODEL, W_IN), s_d),
        'conv_w': nrm(ks[6], (DEPTH, CONV_W, D_RNN), CONV_W ** -0.5),
        'conv_b': nrm(ks[7], (DEPTH, D_RNN), 0.02),
        'w_rg_a': nrm(ks[8], (DEPTH, RNN_BLOCKS, RNN_BW, RNN_BW), RNN_BW ** -0.5),
        'b_rg_a': nrm(ks[9], (DEPTH, RNN_BLOCKS, RNN_BW), 0.02),
        'w_rg_x': nrm(ks[10], (DEPTH, RNN_BLOCKS, RNN_BW, RNN_BW), RNN_BW ** -0.5),
        'b_rg_x': nrm(ks[11], (DEPTH, RNN_BLOCKS, RNN_BW), 0.02),
        'lru_lambda': jnp.log(a0) - jnp.log1p(-a0),
        'w_br_rnn': nrm(ks[13], (DEPTH, D_RNN, D_MODEL), D_RNN ** -0.5),
        'w_br_attn': nrm(ks[14], (DEPTH, D_ATTN, D_MODEL), D_ATTN ** -0.5),
        'w_out': nrm(ks[15], (DEPTH, D_MODEL, D_MODEL), s_d),
        'rel_bias': nrm(ks[16], (N_BUCKETS, N_HEADS), 0.5),
        'w_router': nrm(ks[17], (DEPTH, D_MODEL, N_EXPERTS), s_d),
        'router_bias': nrm(ks[18], (DEPTH, N_EXPERTS), 0.01),
        'w_exp_gate': nrm(ks[19], (DEPTH, N_EXPERTS, D_MODEL, D_EXPERT), s_d),
        'w_exp_up': nrm(ks[20], (DEPTH, N_EXPERTS, D_MODEL, D_EXPERT), s_d),
        'w_exp_down': nrm(ks[21], (DEPTH, N_EXPERTS, D_EXPERT, D_MODEL), D_EXPERT ** -0.5),
        'w_sh_gate': nrm(ks[22], (DEPTH, D_MODEL, D_SHARED), s_d),
        'w_sh_up': nrm(ks[23], (DEPTH, D_MODEL, D_SHARED), s_d),
        'w_sh_down': nrm(ks[24], (DEPTH, D_SHARED, D_MODEL), D_SHARED ** -0.5),
    }


def reference(x, c, w_ada, b_ada, norm_gain, w_in, conv_w, conv_b, w_rg_a, b_rg_a, w_rg_x, b_rg_x,
              lru_lambda, w_br_rnn, w_br_attn, w_out, rel_bias, w_router, router_bias,
              w_exp_gate, w_exp_up, w_exp_down, w_sh_gate, w_sh_up, w_sh_down):
    B, S, D = x.shape
    cond = jax.nn.silu(c)
    for l in range(DEPTH):
        mod = (cond @ w_ada[l] + b_ada[l])[:, None, :]
        shift_m, scale_m, gate_m, shift_f, scale_f, gate_f = jnp.split(mod, N_MOD, axis=-1)
        h = rms_norm(x, norm_gain[l, 0]) * (1.0 + scale_m) + shift_m
        y = token_mixer(h, w_in[l], conv_w[l], conv_b[l], w_rg_a[l], b_rg_a[l], w_rg_x[l], b_rg_x[l],
                        lru_lambda[l], w_br_rnn[l], w_br_attn[l], w_out[l], rel_bias)
        x = x + gate_m * rms_norm(y, norm_gain[l, 1])
        h = rms_norm(x, norm_gain[l, 2]) * (1.0 + scale_f) + shift_f
        y = moe_ffn(h.reshape(B * S, D), w_router[l], router_bias[l], w_exp_gate[l], w_exp_up[l],
                    w_exp_down[l], w_sh_gate[l], w_sh_up[l], w_sh_down[l]).reshape(B, S, D)
        x = x + gate_f * rms_norm(y, norm_gain[l, 3])
    return x
```

```cpp
#include <hip/hip_runtime.h>
#include <cstdio>
#include <cstdint>
#include <type_traits>

#define LAS __attribute__((address_space(3)))
#define GAS __attribute__((address_space(1)))
typedef unsigned short bf16;
typedef short bf16x8 __attribute__((ext_vector_type(8)));
typedef float f32x4 __attribute__((ext_vector_type(4)));
typedef float f32x2 __attribute__((ext_vector_type(2)));
typedef float f32x16 __attribute__((ext_vector_type(16)));
typedef unsigned u32x4 __attribute__((ext_vector_type(4)));
typedef short s16x2 __attribute__((ext_vector_type(2)));
typedef unsigned long long u64x8 __attribute__((ext_vector_type(8)));
typedef unsigned u32x2 __attribute__((ext_vector_type(2)));
typedef __bf16 bf16x2_t __attribute__((ext_vector_type(2)));
typedef unsigned long long u64;

__device__ __forceinline__ unsigned cvt_pk_bf16(float lo, float hi) { f32x2 v = {lo, hi}; bf16x2_t b = __builtin_convertvector(v, bf16x2_t); return __builtin_bit_cast(unsigned, b); }
__device__ __forceinline__ float bf_lo(unsigned w) { return __builtin_bit_cast(float, w << 16); }
__device__ __forceinline__ float bf_hi(unsigned w) { return __builtin_bit_cast(float, w & 0xffff0000u); }
__device__ __forceinline__ float fast_exp2(float x) { return __builtin_amdgcn_exp2f(x); }
__device__ __forceinline__ float fast_rcp(float x) { return __builtin_amdgcn_rcpf(x); }
__device__ __forceinline__ float sigmoidf_(float x) { return fast_rcp(1.0f + fast_exp2(-1.4426950408889634f * x)); }
__device__ __forceinline__ float wave_sum(float v) {
#pragma unroll
    for (int o = 1; o < 64; o <<= 1) v += __shfl_xor(v, o);
    return v;
}

namespace pg8 {
constexpr int BM = 256, BK = 64, HALF = 128, HTB = HALF * BK * 2, STAGE_BYTES = 8 * HTB, NXCD = 8, WGM = 8;
__host__ __device__ __forceinline__ int lds_byte(int r, int c) { const int st = (r >> 4) * 2 + (c >> 5), rr = r & 15, cc = c & 31, ob = rr * 64 + cc * 2; return st * 1024 + (ob ^ (((ob >> 9) & 1) << 5)); }
__host__ __device__ __forceinline__ void stage_rc(int b, int& R, int& C) { const int st = b / 1024, sb = b % 1024, swz = sb ^ (((sb >> 9) & 1) << 5); R = (st >> 1) * 16 + swz / 64; C = (st & 1) * 32 + (swz % 64) / 2; }
__host__ __device__ __forceinline__ int perm32(int rho) { const int n = rho >> 4, i = rho & 15; return 8 * (i >> 2) + 4 * n + (i & 3); }

typedef int i32x8 __attribute__((ext_vector_type(8)));
typedef int i32x4 __attribute__((ext_vector_type(4)));
__device__ __forceinline__ i32x8 ld32(const LAS unsigned char* p) { const i32x4 lo = *(const LAS i32x4*)p, hi = *(const LAS i32x4*)(p + 16); return __builtin_shufflevector(lo, hi, 0, 1, 2, 3, 4, 5, 6, 7); }
struct Unit { int pm, pn, e; };
struct Gemm { int lda, ldb, K; };

template <bool F8> struct DenseOrderT {
    static constexpr bool GATHER = false, FP8 = F8;
    int nM, nN, nwg, G, c;
    const char* A; const char* B; size_t a_tile, b_tile; int a_sh; size_t a_mul;
    __device__ void init(const void* A_, const void* B_, int M, int N, int lda, int ldb, int G_, int c_) {
        nM = M / BM; nN = N / BM; nwg = nM * nN; G = G_; c = c_; A = (const char*)A_; B = (const char*)B_;
        a_tile = (size_t)BM * lda * 2; b_tile = (size_t)BM * ldb * 2; a_sh = 0; a_mul = 0; }
    __device__ bool next(int i, Unit& u) const {
        const long L = (long)i * G + c; if (L >= nwg) return false;
        int wgid = (int)L; { const int q = nwg / NXCD, r = nwg % NXCD, xcd = wgid % NXCD, off = wgid / NXCD; wgid = (xcd < r ? xcd * (q + 1) : r * (q + 1) + (xcd - r) * q) + off; }
        const int nig = WGM * nN, gid = wgid / nig, fm = gid * WGM, gsz = (nM - fm) < WGM ? (nM - fm) : WGM;
        u.pm = fm + ((wgid % nig) % gsz); u.pn = (wgid % nig) / gsz; u.e = 0; return true;
    }
    __device__ __forceinline__ const char* pa(const Unit& u) const { return A + (size_t)u.pm * a_tile + (size_t)(u.pn >> a_sh) * a_mul; }
    __device__ __forceinline__ const char* pb(const Unit& u) const { return B + (size_t)u.pn * b_tile; }
    __device__ __forceinline__ unsigned arow(const Unit&, int) const { return 0u; }
};
using DenseOrder = DenseOrderT<false>; using DenseOrder8 = DenseOrderT<true>;

template <class Epi, class Sched, bool ALIGN_EPI, bool SP2>
__device__ __forceinline__ void gemm_phase(LAS unsigned char* lds, const Gemm g, const Sched& S, const Epi& E) {
    const int tid = threadIdx.x, wid = __builtin_amdgcn_readfirstlane(tid >> 6), lane = tid & 63, wr = wid >> 2, wc = wid & 3, fr = lane & 15, fq = lane >> 4;
    int K = g.K; asm volatile("" : "+s"(K));
    const int nt = K / BK;
    constexpr bool GATHER = Sched::GATHER; constexpr bool FP8 = Sched::FP8;
    unsigned cvA0[2], cvA1[2], nvA0[2], nvA1[2], voffB[2]; int Rr[2], Cc[2];
    const unsigned hstepA = (unsigned)HALF * g.lda * 2u; const size_t hstepB = (size_t)HALF * g.ldb * 2;
#pragma unroll
    for (int i = 0; i < 2; ++i) { int R, C; stage_rc(tid * 16 + i * 8192, R, C); const int Rb = Epi::PERM ? ((R & ~31) + perm32(R & 31)) : R;
        Rr[i] = R; Cc[i] = C; cvA0[i] = (unsigned)(R * g.lda + C) * 2u; cvA1[i] = cvA0[i] + hstepA; nvA0[i] = cvA0[i]; nvA1[i] = cvA1[i]; voffB[i] = (unsigned)(Rb * g.ldb + C) * 2u; }
    const size_t kstep = (size_t)(BK * 2);
    const unsigned ldsw = (unsigned)wid * 1024u;
    const int aoff = lds_byte(wr * 64 + fr, FP8 ? fq * 16 : fq * 8), boff = lds_byte(wc * 32 + fr, FP8 ? fq * 16 : fq * 8);
#define PG8_SA(b, h) (((b) * 2 + (h)) * HTB)
#define PG8_SB(b, h) ((4 + (b) * 2 + (h)) * HTB)
#define PG8_STAGE(bufoff, gbase, voff) do { _Pragma("unroll") for (int _i = 0; _i < 2; ++_i) \
        __builtin_amdgcn_global_load_lds((const unsigned*)((const char*)(gbase) + (voff)[_i]), (LAS unsigned*)(lds + (bufoff) + ldsw + _i * 8192), 16, 0, 0); } while (0)
#define PG8_STAGE_A(bufoff, gbase, half, v0, v1) do { if constexpr (GATHER) { if (half) PG8_STAGE(bufoff, gbase, v1); else PG8_STAGE(bufoff, gbase, v0); } else { PG8_STAGE(bufoff, (gbase) + ((half) ? (size_t)hstepA : (size_t)0), cvA0); } } while (0)
#define PG8_LDA(dst, b, h) do { _Pragma("unroll") for (int m = 0; m < 4; ++m) { if constexpr (FP8) dst[m][0] = ld32(lds + PG8_SA(b, h) + aoff + m * 2048); \
        else { _Pragma("unroll") for (int k = 0; k < 2; ++k) dst[m][k] = *(const LAS FragT*)(lds + PG8_SA(b, h) + aoff + m * 2048 + k * 1024); } } } while (0)
#define PG8_LDB(dst, b, h) do { _Pragma("unroll") for (int n = 0; n < 2; ++n) { if constexpr (FP8) dst[n][0] = ld32(lds + PG8_SB(b, h) + boff + n * 2048); \
        else { _Pragma("unroll") for (int k = 0; k < 2; ++k) dst[n][k] = *(const LAS FragT*)(lds + PG8_SB(b, h) + boff + n * 2048 + k * 1024); } } } while (0)
#define PG8_MMA(ai, bj, At, Bt) do { __builtin_amdgcn_s_setprio(1); _Pragma("unroll") for (int m = 0; m < 4; ++m) _Pragma("unroll") for (int n = 0; n < 2; ++n) { \
        if constexpr (FP8) asm volatile("v_mfma_scale_f32_16x16x128_f8f6f4 %0, %1, %2, %0, %3, %3 op_sel_hi:[0,0,0]" : "+v"(acc[ai][bj][m][n]) : "v"(Bt[n][0]), "v"(At[m][0]), "v"(one_scale)); \
        else { _Pragma("unroll") for (int k = 0; k < 2; ++k) acc[ai][bj][m][n] = __builtin_amdgcn_mfma_f32_16x16x32_bf16(Bt[n][k], At[m][k], acc[ai][bj][m][n], 0, 0, 0); } } \
        __builtin_amdgcn_s_setprio(0); } while (0)
#define PG8_WAIT_V(n) asm volatile("s_waitcnt vmcnt(" #n ")" ::: "memory")
#define PG8_WAIT_L(n) asm volatile("s_waitcnt lgkmcnt(" #n ")" ::: "memory")
#define PG8_BAR __builtin_amdgcn_s_barrier()
#define PG8_SCHED __builtin_amdgcn_sched_barrier(0)
    Unit cur, nxt; int ui = 0;
    if (!S.next(0, cur)) return;
    f32x4 acc[2][2][4][2];
#pragma unroll
    for (int a = 0; a < 2; ++a)
#pragma unroll
        for (int b = 0; b < 2; ++b)
#pragma unroll
            for (int m = 0; m < 4; ++m)
#pragma unroll
                for (int n = 0; n < 2; ++n) acc[a][b][m][n] = (f32x4){0.f, 0.f, 0.f, 0.f};
    using FragT = typename std::conditional<FP8, i32x8, bf16x8>::type; constexpr int NK = FP8 ? 1 : 2;
    FragT At[4][NK], B0[2][NK], B1[2][NK]; const int one_scale = 0x7F7F7F7F;
    const char* cA = S.pa(cur); const char* cB = S.pb(cur);
    if constexpr (GATHER) {
#pragma unroll
        for (int i = 0; i < 2; ++i) { cvA0[i] = S.arow(cur, Rr[i]) * (unsigned)(g.lda * 2) + (unsigned)Cc[i] * 2u; cvA1[i] = S.arow(cur, HALF + Rr[i]) * (unsigned)(g.lda * 2) + (unsigned)Cc[i] * 2u; }
    }
    static_assert(SP2, "only the SP2 loop is carried here");
    PG8_STAGE(PG8_SB(0, 0), cB, voffB); PG8_STAGE(PG8_SB(0, 1), cB + hstepB, voffB); PG8_STAGE_A(PG8_SA(0, 0), cA, 0, cvA0, cvA1); PG8_STAGE_A(PG8_SA(0, 1), cA, 1, cvA0, cvA1);
    if (wr == 1) PG8_BAR;
    PG8_WAIT_V(2); PG8_BAR;
    PG8_STAGE(PG8_SB(1, 0), cB + kstep, voffB); PG8_STAGE_A(PG8_SA(1, 0), cA + kstep, 0, cvA0, cvA1); PG8_STAGE(PG8_SB(1, 1), cB + hstepB + kstep, voffB);
    PG8_WAIT_V(6); PG8_BAR;
    for (;;) {
        const bool has_next = S.next(ui + 1, nxt);
        const char* nA = has_next ? S.pa(nxt) : cA; const char* nB = has_next ? S.pb(nxt) : cB;
        for (int t = 0; t < nt; t += 2) {
            const bool last = (t == nt - 2);
            const char* a1 = cA + (size_t)(t + 1) * kstep;
            const char* a2 = last ? nA : cA + (size_t)(t + 2) * kstep; const char* b2 = last ? nB : cB + (size_t)(t + 2) * kstep;
            const char* a3 = a2 + kstep; const char* b3 = b2 + kstep;
            unsigned xv0[2], xv1[2];
            if constexpr (GATHER) {
                if (last && has_next) {
#pragma unroll
                    for (int i = 0; i < 2; ++i) { nvA0[i] = S.arow(nxt, Rr[i]) * (unsigned)(g.lda * 2) + (unsigned)Cc[i] * 2u; nvA1[i] = S.arow(nxt, HALF + Rr[i]) * (unsigned)(g.lda * 2) + (unsigned)Cc[i] * 2u; }
                }
#pragma unroll
                for (int i = 0; i < 2; ++i) { xv0[i] = (last && has_next) ? nvA0[i] : cvA0[i]; xv1[i] = (last && has_next) ? nvA1[i] : cvA1[i]; }
            } else { xv0[0] = xv0[1] = xv1[0] = xv1[1] = 0u; }
            PG8_LDB(B0, 0, 0); PG8_LDB(B1, 0, 1); PG8_SCHED; PG8_LDA(At, 0, 0); PG8_STAGE_A(PG8_SA(1, 1), a1, 1, cvA0, cvA1);
            PG8_WAIT_V(8); PG8_WAIT_L(0); PG8_BAR; PG8_MMA(0, 0, At, B0); PG8_MMA(0, 1, At, B1); PG8_BAR; PG8_SCHED;
            PG8_LDA(At, 0, 1); PG8_STAGE(PG8_SB(0, 0), b2, voffB); PG8_STAGE(PG8_SB(0, 1), b2 + hstepB, voffB); PG8_STAGE_A(PG8_SA(0, 0), a2, 0, xv0, xv1);
            PG8_WAIT_V(8); PG8_WAIT_L(0); PG8_BAR; PG8_MMA(1, 0, At, B0); PG8_MMA(1, 1, At, B1); PG8_BAR; PG8_SCHED;
            PG8_LDB(B0, 1, 0); PG8_LDB(B1, 1, 1); PG8_SCHED; PG8_LDA(At, 1, 0); PG8_STAGE_A(PG8_SA(0, 1), a2, 1, xv0, xv1);
            PG8_WAIT_V(8); PG8_WAIT_L(0); PG8_BAR; PG8_MMA(0, 0, At, B0); PG8_MMA(0, 1, At, B1); PG8_BAR; PG8_SCHED;
            PG8_LDA(At, 1, 1); PG8_STAGE(PG8_SB(1, 0), b3, voffB); PG8_STAGE(PG8_SB(1, 1), b3 + hstepB, voffB); PG8_STAGE_A(PG8_SA(1, 0), a3, 0, xv0, xv1);
            PG8_WAIT_V(8); PG8_WAIT_L(0); PG8_BAR; PG8_MMA(1, 0, At, B0); PG8_MMA(1, 1, At, B1); PG8_BAR; PG8_SCHED;
        }
        if constexpr (ALIGN_EPI) { if (wr == 0) PG8_BAR; }
        E(acc, cur, wr, wc, fr, fq);
        if (!has_next) break;
#pragma unroll
        for (int a = 0; a < 2; ++a)
#pragma unroll
            for (int b = 0; b < 2; ++b)
#pragma unroll
                for (int m = 0; m < 4; ++m)
#pragma unroll
                    for (int n = 0; n < 2; ++n) acc[a][b][m][n] = (f32x4){0.f, 0.f, 0.f, 0.f};
        cur = nxt; cA = nA; cB = nB; ++ui;
        if constexpr (GATHER) {
#pragma unroll
            for (int i = 0; i < 2; ++i) { cvA0[i] = nvA0[i]; cvA1[i] = nvA1[i]; }
        }
        if constexpr (ALIGN_EPI) { if (wr == 1) PG8_BAR; }
    }
    PG8_WAIT_V(0);
    if constexpr (!ALIGN_EPI) { if (wr == 0) PG8_BAR; }
    PG8_BAR;
#undef PG8_SA
#undef PG8_SB
#undef PG8_STAGE
#undef PG8_STAGE_A
#undef PG8_LDA
#undef PG8_LDB
#undef PG8_MMA
#undef PG8_WAIT_V
#undef PG8_WAIT_L
#undef PG8_BAR
#undef PG8_SCHED
}
}

#define XB_TMO      128
#define XB_XCNT(j)  (256  + 64 * (j))
#define XB_XSUB(j)  (1280 + 64 * (j))
#define XB_XGEN(j)  (2304 + 64 * (j))
#define XB_TOP      3328
#define XB_TOPGEN   3392
#define XCD_BAR_WORDS 3456
#define XB_SPIN_CAP (1u << 18)

__device__ __forceinline__ unsigned xb_ld(unsigned* p)              { return __hip_atomic_load(p, __ATOMIC_RELAXED, __HIP_MEMORY_SCOPE_AGENT); }
__device__ __forceinline__ unsigned xb_add(unsigned* p, unsigned v) { return __hip_atomic_fetch_add(p, v, __ATOMIC_RELAXED, __HIP_MEMORY_SCOPE_AGENT); }
__device__ __forceinline__ unsigned xb_xcc_id() { return (unsigned)__builtin_amdgcn_s_getreg((3 << 11) | 20) & 0xFu; }
#define XB_SPIN(cond, bar) do { unsigned _sp = 0; while (cond) { __builtin_amdgcn_s_sleep(1); \
    if ((++_sp & 255u) == 0u) { if (xb_ld(&(bar)[XB_TMO])) break; if (_sp > XB_SPIN_CAP) { atomicAdd(&(bar)[XB_TMO], 1u); break; } } } } while (0)

struct XcdBarrier { unsigned* bar; unsigned x; volatile LAS unsigned* st; };

__device__ __forceinline__ XcdBarrier xcd_barrier_post(unsigned* bar, volatile LAS unsigned* st) {
    XcdBarrier b; b.bar = bar; b.x = xb_xcc_id(); b.st = st;
    if (threadIdx.x == 0) (void)xb_add(&bar[XB_XCNT(b.x)], 1u);
    return b;
}
__device__ __forceinline__ void xcd_barrier_complete(unsigned* bar, unsigned x, unsigned& nloc, unsigned& nx) {
    const unsigned G = gridDim.x * gridDim.y * gridDim.z;
    unsigned sum, cnt, mine, sp = 0u;
    for (;;) {
        sum = 0u; cnt = 0u; mine = 0u;
#pragma unroll
        for (unsigned j = 0; j < 16; ++j) { const unsigned c = xb_ld(&bar[XB_XCNT(j)]); sum += c; cnt += (c > 0u) ? 1u : 0u; mine = (j == x) ? c : mine; }
        if (sum == G) break;
        __builtin_amdgcn_s_sleep(1);
        if ((++sp & 255u) == 0u) { if (xb_ld(&bar[XB_TMO])) break; if (sp > XB_SPIN_CAP) { atomicAdd(&bar[XB_TMO], 1u); break; } }
    }
    nloc = mine > 0u ? mine : 1u; nx = cnt > 0u ? cnt : 1u;
}
__device__ __forceinline__ void xcd_barrier(const XcdBarrier& b) {
    asm volatile("s_waitcnt vmcnt(0)" ::: "memory");
    __syncthreads();
    if (threadIdx.x == 0) {
        unsigned* bar = b.bar;
        __builtin_amdgcn_s_waitcnt(0);
        unsigned nloc = b.st[0], nx = b.st[1];
        if (nloc == 0u) { xcd_barrier_complete(bar, b.x, nloc, nx); b.st[0] = nloc; b.st[1] = nx; }
        const unsigned old = xb_add(&bar[XB_XSUB(b.x)], 1u);
        const unsigned gen = old / nloc;
        if (old + 1u == (gen + 1u) * nloc) {
            __builtin_amdgcn_fence(__ATOMIC_RELEASE, "agent");
            asm volatile("s_waitcnt vmcnt(0)" ::: "memory");
            const unsigned og = xb_add(&bar[XB_TOP], 1u);
            const unsigned tg = og / nx;
            if (og + 1u == (tg + 1u) * nx) xb_add(&bar[XB_TOPGEN], 1u);
            else XB_SPIN(xb_ld(&bar[XB_TOPGEN]) == tg, bar);
            __builtin_amdgcn_fence(__ATOMIC_ACQUIRE, "agent");
            xb_add(&bar[XB_XGEN(b.x)], 1u);
            asm volatile("s_waitcnt vmcnt(0)" ::: "memory");
        } else {
            XB_SPIN(xb_ld(&bar[XB_XGEN(b.x)]) == gen, bar);
            __builtin_amdgcn_fence(__ATOMIC_ACQUIRE, "agent");
            asm volatile("s_waitcnt vmcnt(0)" ::: "memory");
        }
    }
    __syncthreads();
}

constexpr int NB = 4, SEQ = 8192, DM = 1024, NTOK = NB * SEQ, WIN = 8272, NEXP = 64, DEXP = 256, TOPK = 8;
constexpr int C_UGATE = 1024, C_Q = 2048, C_V = 4096, C_QI = 5120, C_GLR = 6224;
constexpr int NWAVES = 8, NTHR = 512;
constexpr float EPSN = 1e-6f, LOG2E = 1.4426950408889634f;
constexpr float QSCALE = 0.08838834764831845f * 1.4426950408889634f;
constexpr size_t MiB = 1u << 20;
constexpr size_t WS_CTL = 0, CTL_ZERO_BYTES = 1 * MiB;
constexpr int CW_BAR = 4096, CW_MOD = 16384, CW_CNT = 65536, CW_CUR = 65536 + 64, CW_NT = 65536 + 128;
constexpr size_t WS_TOKSEL = 1 * MiB, WS_TOKW = 2 * MiB, WS_LISTTOK = 3 * MiB, WS_LISTW = 4 * MiB + MiB / 2, WS_TILEE = 6 * MiB, WS_CHA = 8 * MiB, WS_CHH = 10 * MiB, WS_SPL = 12 * MiB, WS_LISTP = 13 * MiB;
constexpr size_t WS_WIN_T = 17 * MiB, WS_WG_T = 34 * MiB, WS_WBRR_T = 35 * MiB, WS_WBRA_T = 37 * MiB, WS_WOUT_T = 39 * MiB, WS_WRT_T = 41 * MiB, WS_WSHGU_T = 42 * MiB, WS_WSHD_T = 43 * MiB, WS_WQKV8 = 44 * MiB, WS_WGL8 = WS_WIN_T + (size_t)C_Q * 2048, WS_WBRA8 = WS_WGL8 + 2 * MiB;
constexpr size_t S0 = 48 * MiB, S1 = 112 * MiB, S2 = 176 * MiB, S3 = 240 * MiB, S4 = 304 * MiB, S5 = 368 * MiB, S6 = 432 * MiB, SX = 496 * MiB, WS_NEED = 504 * MiB;
constexpr size_t WS_H = S0, WS_URNN = S1, WS_GGATE = S2, WS_XC = S3, WS_LOGA = S4, WS_BB = S5, WS_YRNN = S1;
constexpr size_t WS_QI = S3, WS_KI = SX, WS_WI = SX + 4 * MiB, WS_SCR = S4, WS_MASK = S6;
constexpr size_t WS_Q = S2, WS_K = S3, WS_VT = S4, WS_YATT = S5, WS_H8 = S6 + 32 * MiB;
constexpr size_t WS_GLR = S2, WS_GLA = S3, WS_M1 = S4, WS_Y1 = S0;
constexpr size_t WS_H2 = S2, WS_WEGU = S3, WS_WED = S4, WS_ACTSH = S4 + 32 * MiB, WS_LOGITS = S4 + 48 * MiB, WS_ACT = S5, WS_Y2 = S0, WS_SLOT = S2, WS_WEGU8 = S3, WS_H2F8 = S3 + 32 * MiB, WS_WED8 = S4, WS_ACT8 = S5, WS_SLOTB2 = S5 + 68 * MiB;
__device__ __forceinline__ unsigned char* slot_row(unsigned char* ws, int pair) { return (pair < 131072 ? ws + S2 + (size_t)pair * 1024 : (pair < 196608 ? ws + S1 + (size_t)(pair - 131072) * 1024 : ws + WS_SLOTB2 + (size_t)(pair - 196608) * 1024)); }
constexpr int LDS_BYTES = 147456, LDSCTL_OFF = 145408;

using pg8::Unit;
#define EPI_ROWS for (int ai = 0; ai < 2; ++ai) _Pragma("unroll") for (int m = 0; m < 4; ++m)
__device__ __forceinline__ u32x4 pack8(const f32x4 a, const f32x4 b) { u32x4 w; w.x = cvt_pk_bf16(a[0], a[1]); w.y = cvt_pk_bf16(a[2], a[3]); w.z = cvt_pk_bf16(b[0], b[1]); w.w = cvt_pk_bf16(b[2], b[3]); return w; }
__device__ __forceinline__ void unpack8(const u32x4 w, f32x4& a, f32x4& b) { a[0] = bf_lo(w.x); a[1] = bf_hi(w.x); a[2] = bf_lo(w.y); a[3] = bf_hi(w.y); b[0] = bf_lo(w.z); b[1] = bf_hi(w.z); b[2] = bf_lo(w.w); b[3] = bf_hi(w.w); }
__device__ __forceinline__ float clamp_e4m3(float x) { return __builtin_fminf(__builtin_fmaxf(x, -448.0f), 448.0f); }
__device__ __forceinline__ float gelu_tanh(float x) { const float u = 0.7978845608028654f * (x + 0.044715f * x * x * x); return x * fast_rcp(1.0f + fast_exp2(-2.0f * LOG2E * u)); }

template <int MODE0, int MODE1> struct EpiSplitBf16 {
    static constexpr bool PERM = true;
    bf16* O0; bf16* O1; int ldc; int split; float s0, s1;
    __device__ __forceinline__ void operator()(const f32x4 (&acc)[2][2][4][2], const Unit& u, int wr, int wc, int fr, int fq) const {
        int colt = u.pn * 256; const bool second = colt >= split; bf16* base = second ? O1 : O0; if (second) colt -= split; const float sc = second ? s1 : s0;
        const int row0 = u.pm * 256 + wr * 64 + fr, col0 = colt + wc * 32 + 8 * fq;
#pragma unroll
        EPI_ROWS { bf16* rowp = base + (size_t)(row0 + ai * 128 + m * 16) * ldc + col0;
#pragma unroll
            for (int bj = 0; bj < 2; ++bj) { f32x4 v0 = acc[ai][bj][m][0], v1 = acc[ai][bj][m][1];
                const int mode = second ? MODE1 : MODE0;
                if (mode == 0) { v0 = v0 * sc; v1 = v1 * sc; }
                else if (mode == 1) {
#pragma unroll
                    for (int j = 0; j < 4; ++j) { v0[j] = gelu_tanh(v0[j]); v1[j] = gelu_tanh(v1[j]); } }
                else {
#pragma unroll
                    for (int j = 0; j < 4; ++j) { v0[j] = sigmoidf_(v0[j] * sc); v1[j] = sigmoidf_(v1[j] * sc); } }
                *(u32x4*)(rowp + bj * 128) = pack8(v0, v1); } }
    }
};
struct EpiSplitF8 {
    static constexpr bool PERM = true;
    unsigned char* O0; unsigned char* O1; int ldc; int split; float s0, s1;
    __device__ __forceinline__ void operator()(const f32x4 (&acc)[2][2][4][2], const Unit& u, int wr, int wc, int fr, int fq) const {
        int colt = u.pn * 256; const bool second = colt >= split; unsigned char* base = second ? O1 : O0; if (second) colt -= split; const float sc = second ? s1 : s0;
        const int row0 = u.pm * 256 + wr * 64 + fr, col0 = colt + wc * 32 + 8 * fq;
#pragma unroll
        EPI_ROWS { unsigned char* rowp = base + (size_t)(row0 + ai * 128 + m * 16) * ldc + col0;
#pragma unroll
            for (int bj = 0; bj < 2; ++bj) { f32x4 a = acc[ai][bj][m][0] * sc, b = acc[ai][bj][m][1] * sc;
#pragma unroll
                for (int j = 0; j < 4; ++j) { a[j] = clamp_e4m3(a[j]); b[j] = clamp_e4m3(b[j]); }
                int w0 = __builtin_amdgcn_cvt_pk_fp8_f32(a[0], a[1], 0, false); w0 = __builtin_amdgcn_cvt_pk_fp8_f32(a[2], a[3], w0, true);
                int w1 = __builtin_amdgcn_cvt_pk_fp8_f32(b[0], b[1], 0, false); w1 = __builtin_amdgcn_cvt_pk_fp8_f32(b[2], b[3], w1, true);
                *(u32x2*)(rowp + bj * 128) = (u32x2){(unsigned)w0, (unsigned)w1}; } }
    }
};
struct EpiIdx {
    static constexpr bool PERM = true;
    bf16* QI; bf16* KI; float* WI;
    __device__ __forceinline__ void operator()(const f32x4 (&acc)[2][2][4][2], const Unit& u, int wr, int wc, int fr, int fq) const {
        const int row0 = u.pm * 256 + wr * 64 + fr;
        if (u.pn < 4) { const int col0 = u.pn * 256 + wc * 32 + 8 * fq;
#pragma unroll
            EPI_ROWS { bf16* rowp = QI + (size_t)(row0 + ai * 128 + m * 16) * 1024 + col0;
#pragma unroll
                for (int bj = 0; bj < 2; ++bj) *(u32x4*)(rowp + bj * 128) = pack8(acc[ai][bj][m][0] * 0.125f, acc[ai][bj][m][1] * 0.125f); }
        } else { const int col0 = wc * 32 + 8 * fq;
#pragma unroll
            EPI_ROWS { const size_t row = (size_t)(row0 + ai * 128 + m * 16);
                if (col0 < 64) *(u32x4*)(KI + row * 64 + col0) = pack8(acc[ai][0][m][0], acc[ai][0][m][1]);
                else if (col0 < 80) { *(f32x4*)(WI + row * 16 + (col0 - 64)) = acc[ai][0][m][0] * 0.125f; *(f32x4*)(WI + row * 16 + (col0 - 64) + 4) = acc[ai][0][m][1] * 0.125f; } }
        }
    }
};
struct EpiBf16 {
    static constexpr bool PERM = true;
    bf16* O; int ldc;
    __device__ __forceinline__ void operator()(const f32x4 (&acc)[2][2][4][2], const Unit& u, int wr, int wc, int fr, int fq) const {
        const int row0 = u.pm * 256 + wr * 64 + fr, col0 = u.pn * 256 + wc * 32 + 8 * fq;
#pragma unroll
        EPI_ROWS { bf16* rowp = O + (size_t)(row0 + ai * 128 + m * 16) * ldc + col0;
#pragma unroll
            for (int bj = 0; bj < 2; ++bj) *(u32x4*)(rowp + bj * 128) = pack8(acc[ai][bj][m][0], acc[ai][bj][m][1]); }
    }
};
template <int MODE> struct EpiMerge {
    static constexpr bool PERM = true;
    bf16* O; const bf16* Gt; float isc;
    __device__ __forceinline__ void operator()(const f32x4 (&acc)[2][2][4][2], const Unit& u, int wr, int wc, int fr, int fq) const {
        const int row0 = u.pm * 256 + wr * 64 + fr, col0 = u.pn * 256 + wc * 32 + 8 * fq;
#pragma unroll
        EPI_ROWS { const size_t off = (size_t)(row0 + ai * 128 + m * 16) * 1024 + col0;
#pragma unroll
            for (int bj = 0; bj < 2; ++bj) { f32x4 g0, g1; unpack8(*(const u32x4*)(Gt + off + bj * 128), g0, g1);
                f32x4 v0 = g0 * (acc[ai][bj][m][0] * isc), v1 = g1 * (acc[ai][bj][m][1] * isc);
                if (MODE == 1) { f32x4 o0, o1; unpack8(*(const u32x4*)(O + off + bj * 128), o0, o1); v0 = v0 + o0; v1 = v1 + o1; }
                *(u32x4*)(O + off + bj * 128) = pack8(v0, v1); } }
    }
};
struct EpiF32 {
    static constexpr bool PERM = false;
    float* C; int ldc; int ncols;
    __device__ __forceinline__ void operator()(const f32x4 (&acc)[2][2][4][2], const Unit& u, int wr, int wc, int fr, int fq) const {
        const int row0 = u.pm * 256 + wr * 64 + fr, col0 = u.pn * 256 + wc * 32 + 4 * fq;
#pragma unroll
        EPI_ROWS { float* rowp = C + (size_t)(row0 + ai * 128 + m * 16) * ldc + col0;
#pragma unroll
            for (int bj = 0; bj < 2; ++bj)
#pragma unroll
                for (int n = 0; n < 2; ++n) if (col0 + bj * 128 + n * 16 < ncols) *(f32x4*)(rowp + bj * 128 + n * 16) = acc[ai][bj][m][n]; }
    }
};
struct EpiGate {
    static constexpr bool PERM = true;
    const bf16* XC; bf16* LOGA; bf16* BB; const float* b_a; const float* b_x; const float* lam;
    __device__ __forceinline__ void operator()(const f32x4 (&acc)[2][2][4][2], const Unit& u, int wr, int wc, int fr, int fq) const {
        const int row0 = u.pm * 256 + wr * 64 + fr;
#pragma unroll
        for (int n = 0; n < 2; ++n) { const int ch0 = u.pn * 128 + wc * 32 + 8 * fq + 4 * n;
            const f32x4 ba = *(const f32x4*)(b_a + ch0), bx = *(const f32x4*)(b_x + ch0), sp = *(const f32x4*)(lam + ch0);
#pragma unroll
            EPI_ROWS { const size_t off = (size_t)(row0 + ai * 128 + m * 16) * 1024 + ch0;
                const u32x2 xw = *(const u32x2*)(XC + off); const f32x4 xv = {bf_lo(xw.x), bf_hi(xw.x), bf_lo(xw.y), bf_hi(xw.y)};
                f32x4 la, bv;
#pragma unroll
                for (int j = 0; j < 4; ++j) {
                    const float r = sigmoidf_(acc[ai][0][m][n][j] + ba[j]), ig = sigmoidf_(acc[ai][1][m][n][j] + bx[j]);
                    la[j] = r * sp[j]; bv[j] = ig * xv[j]; }
                u32x2 w0, w1; w0.x = cvt_pk_bf16(la[0], la[1]); w0.y = cvt_pk_bf16(la[2], la[3]); w1.x = cvt_pk_bf16(bv[0], bv[1]); w1.y = cvt_pk_bf16(bv[2], bv[3]);
                *(u32x2*)(LOGA + off) = w0; *(u32x2*)(BB + off) = w1; asm volatile("" ::: "memory"); } }
    }
};
struct EpiGlu {
    static constexpr bool PERM = true;
    bf16* ACT; float isc;
    __device__ __forceinline__ void operator()(const f32x4 (&acc)[2][2][4][2], const Unit& u, int wr, int wc, int fr, int fq) const {
        const int row0 = u.pm * 256 + wr * 64 + fr, col0 = u.pn * 128 + wc * 32 + 8 * fq;
#pragma unroll
        EPI_ROWS { f32x4 v0, v1;
#pragma unroll
            for (int j = 0; j < 4; ++j) { const float g0 = acc[ai][0][m][0][j] * isc, g1 = acc[ai][0][m][1][j] * isc; v0[j] = g0 * sigmoidf_(g0) * (acc[ai][1][m][0][j] * isc); v1[j] = g1 * sigmoidf_(g1) * (acc[ai][1][m][1][j] * isc); }
            *(u32x4*)(ACT + (size_t)(row0 + ai * 128 + m * 16) * 256 + col0) = pack8(v0, v1); }
    }
};
struct EpiGlu8 {
    static constexpr bool PERM = true;
    unsigned char* ACT; float isc;
    __device__ __forceinline__ void operator()(const f32x4 (&acc)[2][2][4][2], const Unit& u, int wr, int wc, int fr, int fq) const {
        const int row0 = u.pm * 256 + wr * 64 + fr, col0 = u.pn * 128 + wc * 32 + 8 * fq;
#pragma unroll
        EPI_ROWS { float v[8];
#pragma unroll
            for (int j = 0; j < 4; ++j) { const float g0 = acc[ai][0][m][0][j] * isc, g1 = acc[ai][0][m][1][j] * isc; v[j] = clamp_e4m3(g0 * sigmoidf_(g0) * (acc[ai][1][m][0][j] * isc)); v[4 + j] = clamp_e4m3(g1 * sigmoidf_(g1) * (acc[ai][1][m][1][j] * isc)); }
            int w0 = __builtin_amdgcn_cvt_pk_fp8_f32(v[0], v[1], 0, false); w0 = __builtin_amdgcn_cvt_pk_fp8_f32(v[2], v[3], w0, true);
            int w1 = __builtin_amdgcn_cvt_pk_fp8_f32(v[4], v[5], 0, false); w1 = __builtin_amdgcn_cvt_pk_fp8_f32(v[6], v[7], w1, true);
            *(u32x2*)(ACT + (size_t)(row0 + ai * 128 + m * 16) * 256 + col0) = (u32x2){(unsigned)w0, (unsigned)w1}; }
    }
};
struct EpiSlot {
    static constexpr bool PERM = true;
    unsigned char* ws; const int* list_pair; const float* list_w; float isc;
    __device__ __forceinline__ void operator()(const f32x4 (&acc)[2][2][4][2], const Unit& u, int wr, int wc, int fr, int fq) const {
        const int row0 = u.pm * 256 + wr * 64 + fr, col0 = u.pn * 256 + wc * 32 + 8 * fq;
#pragma unroll
        EPI_ROWS { const int pos = row0 + ai * 128 + m * 16; const float w = list_w[pos] * isc; const int pair = list_pair[pos];
            if (pair >= 0) { unsigned char* rowp = slot_row(ws, pair) + col0;
#pragma unroll
                for (int bj = 0; bj < 2; ++bj) { f32x4 a = acc[ai][bj][m][0] * w, b = acc[ai][bj][m][1] * w;
#pragma unroll
                    for (int j = 0; j < 4; ++j) { a[j] = clamp_e4m3(a[j]); b[j] = clamp_e4m3(b[j]); }
                    int w0 = __builtin_amdgcn_cvt_pk_fp8_f32(a[0], a[1], 0, false); w0 = __builtin_amdgcn_cvt_pk_fp8_f32(a[2], a[3], w0, true);
                    int w1 = __builtin_amdgcn_cvt_pk_fp8_f32(b[0], b[1], 0, false); w1 = __builtin_amdgcn_cvt_pk_fp8_f32(b[2], b[3], w1, true);
                    *(u32x2*)(rowp + bj * 128) = (u32x2){(unsigned)w0, (unsigned)w1}; } } }
    }
};
template <bool GATH, bool F8 = false> struct MoeOrder {
    static constexpr bool GATHER = GATH, FP8 = F8;
    const int* tile_e; const int* list_tok; int nunits, ntn, pn0, G, c; const char* A; const char* B; size_t a_tile, b_e, b_tile;
    __device__ bool next(int i, Unit& u) const {
        int L;
        if ((G & 7) == 0) { const int q = nunits / 8, r = nunits % 8, xcd = c & 7, off = i * (G >> 3) + (c >> 3), len = q + (xcd < r ? 1 : 0); if (off >= len) return false; L = (xcd < r ? xcd * (q + 1) : r * (q + 1) + (xcd - r) * q) + off; }
        else { const long Ll = (long)i * G + c; if (Ll >= nunits) return false; L = (int)Ll; }
        u.pm = L / ntn; u.pn = pn0 + L % ntn; u.e = tile_e[u.pm]; return true; }
    __device__ __forceinline__ const char* pa(const Unit& u) const { return GATH ? A : A + (size_t)u.pm * a_tile; }
    __device__ __forceinline__ const char* pb(const Unit& u) const { return B + (size_t)u.e * b_e + (size_t)u.pn * b_tile; }
    __device__ __forceinline__ unsigned arow(const Unit& u, int r) const { return (unsigned)list_tok[u.pm * 256 + r]; }
};

#define LDS_WAIT() asm volatile("s_waitcnt lgkmcnt(0)" ::: "memory")
__device__ __forceinline__ unsigned lds_add(LAS unsigned* p, unsigned v) { return __hip_atomic_fetch_add(p, v, __ATOMIC_RELAXED, __HIP_MEMORY_SCOPE_WORKGROUP); }

__device__ __forceinline__ void tr_item(const float* W, int ldw, int N, bf16* WT, int ldt, int blk, int blkstride, int rowoff, LAS float* scr, int kb, int nb, int lane) {
    const int k0 = 64 * kb, n0 = 32 * nb;
    float tv[32];
#pragma unroll
    for (int i = 0; i < 32; ++i) { const int kk = 2 * i + (lane >> 5), n = n0 + (lane & 31); tv[i] = (n < N) ? W[(size_t)(k0 + kk) * ldw + n] : 0.f; }
#pragma unroll
    for (int i = 0; i < 32; ++i) { const int kk = 2 * i + (lane >> 5); scr[kk * 33 + (lane & 31)] = tv[i]; }
    LDS_WAIT(); asm volatile("" ::: "memory");
    const int c = lane & 7;
#pragma unroll
    for (int j = 0; j < 4; ++j) { const int nl = (lane >> 3) + 8 * j, n = n0 + nl; const LAS float* s = scr + (8 * c) * 33 + nl;
        u32x4 o; o.x = cvt_pk_bf16(s[0 * 33], s[1 * 33]); o.y = cvt_pk_bf16(s[2 * 33], s[3 * 33]); o.z = cvt_pk_bf16(s[4 * 33], s[5 * 33]); o.w = cvt_pk_bf16(s[6 * 33], s[7 * 33]);
        if (n < N) { const int drow = rowoff + (n / blk) * blkstride + (n % blk); *(u32x4*)(WT + (size_t)drow * ldt + k0 + 8 * c) = o; } }
    LDS_WAIT(); asm volatile("" ::: "memory");
}
__device__ __forceinline__ unsigned cvt4_fp8(float a, float b, float c, float d) { int w = __builtin_amdgcn_cvt_pk_fp8_f32(a, b, 0, false); w = __builtin_amdgcn_cvt_pk_fp8_f32(c, d, w, true); return (unsigned)w; }
__device__ __forceinline__ void tr_item_fp8(const float* W, int ldw, int N, unsigned char* WT, int ldt, int blk, int blkstride, int rowoff, float scale, LAS float* scr, int kb, int nb, int lane) {
    const int k0 = 64 * kb, n0 = 32 * nb;
    float tv[32];
#pragma unroll
    for (int i = 0; i < 32; ++i) { const int kk = 2 * i + (lane >> 5), n = n0 + (lane & 31); tv[i] = (n < N) ? W[(size_t)(k0 + kk) * ldw + n] : 0.f; }
#pragma unroll
    for (int i = 0; i < 32; ++i) { const int kk = 2 * i + (lane >> 5); scr[kk * 33 + (lane & 31)] = tv[i]; }
    LDS_WAIT(); asm volatile("" ::: "memory");
    const int c = lane & 7;
#pragma unroll
    for (int j = 0; j < 4; ++j) { const int nl = (lane >> 3) + 8 * j, n = n0 + nl; const LAS float* s = scr + (8 * c) * 33 + nl;
        u32x2 o; o.x = cvt4_fp8(s[0 * 33] * scale, s[1 * 33] * scale, s[2 * 33] * scale, s[3 * 33] * scale); o.y = cvt4_fp8(s[4 * 33] * scale, s[5 * 33] * scale, s[6 * 33] * scale, s[7 * 33] * scale);
        if (n < N) { const int drow = rowoff + (n / blk) * blkstride + (n % blk); *(u32x2*)(WT + (size_t)drow * ldt + k0 + 8 * c) = o; } }
    LDS_WAIT(); asm volatile("" ::: "memory");
}
__device__ __forceinline__ void tr_matrix(const float* W, int K, int N, int ldw, bf16* WT, int ldt, int blk, int blkstride, int rowoff, LAS float* scr, int gw, int NGW, int lane) {
    const int nbn = (N + 31) / 32, nit = (K / 64) * nbn;
    for (int it = gw; it < nit; it += NGW) tr_item(W, ldw, N, WT, ldt, blk, blkstride, rowoff, scr, it / nbn, it % nbn, lane);
}

struct In {
    const float *x, *c, *w_ada, *b_ada, *norm_gain, *w_in, *conv_w, *conv_b, *w_rg_a, *b_rg_a, *w_rg_x, *b_rg_x, *lru_lambda, *w_br_rnn, *w_br_attn, *w_out, *rel_bias,
                *w_router, *router_bias, *w_exp_gate, *w_exp_up, *w_exp_down, *w_sh_gate, *w_sh_up, *w_sh_down;
};

__device__ __forceinline__ void p0_prologue(const In& in, unsigned char* ws, LAS unsigned char* lds, int vcu, int G) {
    const int tid = threadIdx.x, lane = tid & 63, wave = __builtin_amdgcn_readfirstlane(tid >> 6);
    LAS float* scr = (LAS float*)(lds + wave * 16384);
    const int gw = vcu * NWAVES + wave, NGW = G * NWAVES;
    tr_matrix(in.w_in, 1024, C_Q, WIN, (bf16*)(ws + WS_WIN_T), 1024, 1 << 30, 0, 0, scr, gw, NGW, lane);
    tr_matrix(in.w_in + C_QI, 1024, C_GLR - C_QI, WIN, (bf16*)(ws + WS_WIN_T) + (size_t)C_QI * 1024, 1024, 1 << 30, 0, 0, scr, gw, NGW, lane);
    for (int it = gw; it < 16 * 64; it += NGW) tr_item_fp8(in.w_in + C_GLR, WIN, 2048, ws + WS_WGL8, 1024, 1 << 30, 0, 0, 32.0f, scr, it / 64, it % 64, lane);
    for (int it = gw; it < 16 * 96; it += NGW) tr_item_fp8(in.w_in + C_Q, WIN, 3072, ws + WS_WQKV8, 1024, 1 << 30, 0, 0, 32.0f, scr, it / 96, it % 96, lane);
    tr_matrix(in.w_br_rnn, 1024, 1024, 1024, (bf16*)(ws + WS_WBRR_T), 1024, 1 << 30, 0, 0, scr, gw, NGW, lane);
    for (int it = gw; it < 16 * 32; it += NGW) tr_item_fp8(in.w_br_attn, 1024, 1024, ws + WS_WBRA8, 1024, 1 << 30, 0, 0, 32.0f, scr, it / 32, it % 32, lane);
    tr_matrix(in.w_out, 1024, 1024, 1024, (bf16*)(ws + WS_WOUT_T), 1024, 1 << 30, 0, 0, scr, gw, NGW, lane);
    tr_matrix(in.w_router, 1024, 64, 64, (bf16*)(ws + WS_WRT_T), 1024, 1 << 30, 0, 0, scr, gw, NGW, lane);
    tr_matrix(in.w_sh_gate, 1024, 256, 256, (bf16*)(ws + WS_WSHGU_T), 1024, 128, 256, 0, scr, gw, NGW, lane);
    tr_matrix(in.w_sh_up, 1024, 256, 256, (bf16*)(ws + WS_WSHGU_T), 1024, 128, 256, 128, scr, gw, NGW, lane);
    tr_matrix(in.w_sh_down, 256, 1024, 1024, (bf16*)(ws + WS_WSHD_T), 256, 1 << 30, 0, 0, scr, gw, NGW, lane);
    float* MOD = (float*)(ws + WS_CTL) + CW_MOD; LAS float* part = (LAS float*)(lds + 16384); LAS float* sc_ = (LAS float*)lds;
    __syncthreads();
    if (vcu < 96) { for (int i = tid; i < 4096; i += NTHR) { const float cv = in.c[i]; sc_[i] = cv * sigmoidf_(cv); } }
    __syncthreads();
    for (int jb = vcu; jb < 96; jb += G) { const int j = jb * 64 + lane;
        float a0 = 0.f, a1 = 0.f, a2 = 0.f, a3 = 0.f;
#pragma unroll 16
        for (int k = wave * 128; k < wave * 128 + 128; ++k) { const float w = in.w_ada[(size_t)k * 6144 + j];
            a0 += sc_[k] * w; a1 += sc_[1024 + k] * w; a2 += sc_[2048 + k] * w; a3 += sc_[3072 + k] * w; }
        part[(wave * 4 + 0) * 64 + lane] = a0; part[(wave * 4 + 1) * 64 + lane] = a1; part[(wave * 4 + 2) * 64 + lane] = a2; part[(wave * 4 + 3) * 64 + lane] = a3;
        __syncthreads();
        if (wave < 4) { float sum = in.b_ada[j];
#pragma unroll
            for (int w2 = 0; w2 < 8; ++w2) sum += part[(w2 * 4 + wave) * 64 + lane];
            MOD[wave * 6144 + j] = sum; }
        __syncthreads(); }
    bf16* WG = (bf16*)(ws + WS_WG_T);
    for (int idx = vcu * NTHR + tid; idx < 2048 * 256; idx += G * NTHR) { const int row = idx >> 8, kk = idx & 255, pn = row >> 8, within = row & 255, type = within >> 7, e = within & 127;
        float v = 0.f; if ((kk >> 7) == (pn & 1)) v = (type ? in.w_rg_x : in.w_rg_a)[((size_t)pn * 128 + (kk & 127)) * 128 + e];
        WG[idx] = (bf16)(cvt_pk_bf16(v, 0.f) & 0xffffu); }
    { float* SPL = (float*)(ws + WS_SPL); for (int i = vcu * NTHR + tid; i < 1024; i += G * NTHR) SPL[i] = -8.0f * LOG2E * log1pf(__expf(-in.lru_lambda[i])); }
    u32x4* z = (u32x4*)(ws + WS_WRT_T + 64 * 1024 * 2);
    for (int i = vcu * NTHR + tid; i < 192 * 1024 * 2 / 16; i += G * NTHR) z[i] = (u32x4){0u, 0u, 0u, 0u};
}

__device__ __forceinline__ void p1_norm_rows(const In& in, unsigned char* ws, int vcu, int G) {
    const int tid = threadIdx.x, lane = tid & 63, wave = __builtin_amdgcn_readfirstlane(tid >> 6);
    const int gw = vcu * NWAVES + wave, NGW = G * NWAVES;
    const float* MOD = (const float*)(ws + WS_CTL) + CW_MOD; bf16* H = (bf16*)(ws + WS_H);
    for (int m0 = gw; m0 < NTOK; m0 += 2 * NGW) {
        f32x4 v[2][4]; int mr[2];
#pragma unroll
        for (int q = 0; q < 2; ++q) { mr[q] = (m0 + q * NGW < NTOK) ? m0 + q * NGW : m0; const f32x4* xr = (const f32x4*)(in.x + (size_t)mr[q] * DM) + lane;
#pragma unroll
            for (int j = 0; j < 4; ++j) v[q][j] = xr[64 * j]; }
#pragma unroll
        for (int q = 0; q < 2; ++q) { const int mrow = mr[q], b = mrow >> 13; float s2 = 0.f;
#pragma unroll
            for (int j = 0; j < 4; ++j) s2 += (v[q][j].x * v[q][j].x + v[q][j].y * v[q][j].y) + (v[q][j].z * v[q][j].z + v[q][j].w * v[q][j].w);
            const float rstd = 1.0f / sqrtf(wave_sum(s2) * (1.f / DM) + EPSN);
            u64* o8 = (u64*)(H + (size_t)mrow * DM) + lane;
#pragma unroll
            for (int j = 0; j < 4; ++j) { const int col = 256 * j + 4 * lane; const f32x4 g = *(const f32x4*)(in.norm_gain + col), sh = *(const f32x4*)(MOD + b * 6144 + col), sc = *(const f32x4*)(MOD + b * 6144 + 1024 + col);
                const f32x4 r = (v[q][j] * rstd * g) * (sc + 1.0f) + sh; o8[64 * j] = (u64)cvt_pk_bf16(r.x, r.y) | ((u64)cvt_pk_bf16(r.z, r.w) << 32);
                ((unsigned*)(ws + WS_H8 + (size_t)mrow * DM))[64 * j + lane] = cvt4_fp8(clamp_e4m3(r.x), clamp_e4m3(r.y), clamp_e4m3(r.z), clamp_e4m3(r.w)); } } }
}

__device__ __forceinline__ void p3_conv(const In& in, unsigned char* ws, int vcu, int G) {
    const int gt = vcu * NTHR + threadIdx.x, NT = G * NTHR;
    const bf16* U = (const bf16*)(ws + WS_URNN); bf16* XC = (bf16*)(ws + WS_XC);
    const bool fixed_ch = (NT % 128) == 0; const int ch0 = (gt & 127) * 8;
    float cw[4][8], cb[8];
#pragma unroll
    for (int j = 0; j < 8; ++j) { cb[j] = in.conv_b[ch0 + j];
#pragma unroll
        for (int k = 0; k < 4; ++k) cw[k][j] = in.conv_w[k * 1024 + ch0 + j]; }
    for (int it = gt; it < NTOK * 128; it += NT) { const int row = it >> 7, ch = (it & 127) * 8, t = row & (SEQ - 1);
        if (!fixed_ch) {
#pragma unroll
            for (int j = 0; j < 8; ++j) { cb[j] = in.conv_b[ch + j];
#pragma unroll
                for (int k = 0; k < 4; ++k) cw[k][j] = in.conv_w[k * 1024 + ch + j]; } }
        u32x4 uu[4];
#pragma unroll
        for (int k = 0; k < 4; ++k) uu[k] = (t - 3 + k >= 0) ? *(const u32x4*)(U + (size_t)(row - 3 + k) * 1024 + ch) : (u32x4){0u, 0u, 0u, 0u};
        float a[8];
#pragma unroll
        for (int j = 0; j < 8; ++j) a[j] = cb[j];
#pragma unroll
        for (int k = 0; k < 4; ++k) { f32x4 u0, u1; unpack8(uu[k], u0, u1);
#pragma unroll
            for (int j = 0; j < 4; ++j) { a[j] += cw[k][j] * u0[j]; a[4 + j] += cw[k][4 + j] * u1[j]; } }
        *(u32x4*)(XC + (size_t)row * 1024 + ch) = pack8((f32x4){a[0], a[1], a[2], a[3]}, (f32x4){a[4], a[5], a[6], a[7]}); }
}

constexpr int SCH = 64, NCH = SEQ / SCH;
__device__ __forceinline__ void p5_scan_local(unsigned char* ws, int vcu, int G) {
    const int gt = vcu * NTHR + threadIdx.x, NT = G * NTHR;
    const bf16* LA = (const bf16*)(ws + WS_LOGA); const bf16* BBp = (const bf16*)(ws + WS_BB); float* CHA = (float*)(ws + WS_CHA); float* CHH = (float*)(ws + WS_CHH);
    for (int it = gt; it < NB * NCH * 256; it += NT) { const int cq = it & 255, bc = it >> 8; const size_t base = (size_t)bc * SCH * 1024 + cq * 4;
        f32x4 h = {0.f, 0.f, 0.f, 0.f}, sl = {0.f, 0.f, 0.f, 0.f};
#pragma unroll 8
        for (int r = 0; r < SCH; ++r) { const u32x2 la = *(const u32x2*)(LA + base + (size_t)r * 1024), bb = *(const u32x2*)(BBp + base + (size_t)r * 1024);
            const f32x4 l = {bf_lo(la.x), bf_hi(la.x), bf_lo(la.y), bf_hi(la.y)}, bv = {bf_lo(bb.x), bf_hi(bb.x), bf_lo(bb.y), bf_hi(bb.y)};
#pragma unroll
            for (int j = 0; j < 4; ++j) { const float a = fast_exp2(l[j]); h[j] = a * h[j] + __builtin_amdgcn_sqrtf(1.0f - a * a) * bv[j]; sl[j] += l[j]; } }
        *(f32x4*)(CHA + (size_t)it * 4) = sl; *(f32x4*)(CHH + (size_t)it * 4) = h; }
}
__device__ __forceinline__ void p7_scan_final(unsigned char* ws, int vcu, int G) {
    const int gt = vcu * NTHR + threadIdx.x, NT = G * NTHR;
    const bf16* LA = (const bf16*)(ws + WS_LOGA); const bf16* BBp = (const bf16*)(ws + WS_BB); const bf16* GG = (const bf16*)(ws + WS_GGATE); bf16* Y = (bf16*)(ws + WS_YRNN);
    const float* CHA = (const float*)(ws + WS_CHA); const float* CHH = (const float*)(ws + WS_CHH);
    for (int it = gt; it < NB * NCH * 256; it += NT) { const int cq = it & 255, bc = it >> 8, ch = bc & (NCH - 1), b = bc / NCH; const size_t base = (size_t)bc * SCH * 1024 + cq * 4;
        f32x4 h = {0.f, 0.f, 0.f, 0.f};
        for (int c0 = 0; c0 < ch; c0 += 8) { f32x4 av[8], hv[8];
#pragma unroll
            for (int u = 0; u < 8; ++u) { const int c2 = (c0 + u < ch) ? c0 + u : ch - 1; const size_t o = ((size_t)(b * NCH + c2) * 256 + cq) * 4; av[u] = *(const f32x4*)(CHA + o); hv[u] = *(const f32x4*)(CHH + o); }
#pragma unroll
            for (int u = 0; u < 8; ++u) if (c0 + u < ch) {
#pragma unroll
                for (int j = 0; j < 4; ++j) h[j] = fast_exp2(av[u][j]) * h[j] + hv[u][j]; } }
#pragma unroll 8
        for (int r = 0; r < SCH; ++r) { const size_t o = base + (size_t)r * 1024; const u32x2 la = *(const u32x2*)(LA + o), bb = *(const u32x2*)(BBp + o), gg = *(const u32x2*)(GG + o);
            const f32x4 l = {bf_lo(la.x), bf_hi(la.x), bf_lo(la.y), bf_hi(la.y)}, bv = {bf_lo(bb.x), bf_hi(bb.x), bf_lo(bb.y), bf_hi(bb.y)}, gv = {bf_lo(gg.x), bf_hi(gg.x), bf_lo(gg.y), bf_hi(gg.y)};
#pragma unroll
            for (int j = 0; j < 4; ++j) { const float a = fast_exp2(l[j]); h[j] = a * h[j] + __builtin_amdgcn_sqrtf(1.0f - a * a) * bv[j]; }
            u32x2 w; w.x = cvt_pk_bf16(h[0] * gv[0], h[1] * gv[1]); w.y = cvt_pk_bf16(h[2] * gv[2], h[3] * gv[3]); *(u32x2*)(Y + o) = w; } }
}

__device__ __forceinline__ void p13_mid(const In& in, unsigned char* ws, float* out, LAS unsigned char* lds, int vcu, int G) {
    const int tid = threadIdx.x, lane = tid & 63, wave = __builtin_amdgcn_readfirstlane(tid >> 6);
    const int gw = vcu * NWAVES + wave, NGW = G * NWAVES;
    const float* MOD = (const float*)(ws + WS_CTL) + CW_MOD; const bf16* Y1 = (const bf16*)(ws + WS_Y1); bf16* H2 = (bf16*)(ws + WS_H2);
    for (int m0 = gw; m0 < NTOK; m0 += 2 * NGW) {
        f32x4 v[2][4], xv[2][4]; int mr[2];
#pragma unroll
        for (int q = 0; q < 2; ++q) { mr[q] = (m0 + q * NGW < NTOK) ? m0 + q * NGW : m0;
            const u32x2* yr = (const u32x2*)(Y1 + (size_t)mr[q] * DM) + lane; const f32x4* xr = (const f32x4*)(in.x + (size_t)mr[q] * DM) + lane;
#pragma unroll
            for (int j = 0; j < 4; ++j) { const u32x2 w = yr[64 * j]; v[q][j] = (f32x4){bf_lo(w.x), bf_hi(w.x), bf_lo(w.y), bf_hi(w.y)}; xv[q][j] = xr[64 * j]; } }
#pragma unroll
        for (int q = 0; q < 2; ++q) { const int mrow = mr[q], b = mrow >> 13; float s2 = 0.f;
            if (q == 1 && m0 + NGW >= NTOK) continue;
#pragma unroll
            for (int j = 0; j < 4; ++j) s2 += (v[q][j].x * v[q][j].x + v[q][j].y * v[q][j].y) + (v[q][j].z * v[q][j].z + v[q][j].w * v[q][j].w);
            const float rstd = 1.0f / sqrtf(wave_sum(s2) * (1.f / DM) + EPSN); float s3 = 0.f;
            f32x4* o4 = (f32x4*)(out + (size_t)mrow * DM) + lane;
#pragma unroll
            for (int j = 0; j < 4; ++j) { const int col = 256 * j + 4 * lane; const f32x4 g = *(const f32x4*)(in.norm_gain + 1024 + col), gm = *(const f32x4*)(MOD + b * 6144 + 2048 + col);
                v[q][j] = xv[q][j] + gm * (v[q][j] * rstd * g); o4[64 * j] = v[q][j]; s3 += (v[q][j].x * v[q][j].x + v[q][j].y * v[q][j].y) + (v[q][j].z * v[q][j].z + v[q][j].w * v[q][j].w); }
            const float rstd2 = 1.0f / sqrtf(wave_sum(s3) * (1.f / DM) + EPSN);
            u64* o8 = (u64*)(H2 + (size_t)mrow * DM) + lane;
#pragma unroll
            for (int j = 0; j < 4; ++j) { const int col = 256 * j + 4 * lane; const f32x4 g = *(const f32x4*)(in.norm_gain + 2048 + col), sh = *(const f32x4*)(MOD + b * 6144 + 3072 + col), sc = *(const f32x4*)(MOD + b * 6144 + 4096 + col);
                const f32x4 r = (v[q][j] * rstd2 * g) * (sc + 1.0f) + sh; o8[64 * j] = (u64)cvt_pk_bf16(r.x, r.y) | ((u64)cvt_pk_bf16(r.z, r.w) << 32);
                ((unsigned*)(ws + WS_H2F8 + (size_t)mrow * DM))[64 * j + lane] = cvt4_fp8(clamp_e4m3(r.x), clamp_e4m3(r.y), clamp_e4m3(r.z), clamp_e4m3(r.w)); } } }
    LAS float* scr = (LAS float*)(lds + wave * 16384);
    for (int it = gw; it < NEXP * 384; it += NGW) { const int e = it / 384, r = it % 384, which = r >> 7, sub = r & 127;
        if (which == 0) tr_item_fp8(in.w_exp_gate + (size_t)e * 1024 * 256, 256, 256, (unsigned char*)(ws + WS_WEGU8) + (size_t)e * 512 * 1024, 1024, 128, 256, 0, 32.0f, scr, sub >> 3, sub & 7, lane);
        else if (which == 1) tr_item_fp8(in.w_exp_up + (size_t)e * 1024 * 256, 256, 256, (unsigned char*)(ws + WS_WEGU8) + (size_t)e * 512 * 1024, 1024, 128, 256, 128, 32.0f, scr, sub >> 3, sub & 7, lane);
        else tr_item_fp8(in.w_exp_down + (size_t)e * 256 * 1024, 1024, 1024, (unsigned char*)(ws + WS_WED8) + (size_t)e * 1024 * 256, 256, 1 << 30, 0, 0, 32.0f, scr, sub >> 5, sub & 31, lane); }
}

__device__ __forceinline__ void route_tile(const In& in, unsigned char* ws, int t0, int wave, int lane, unsigned& mycount) {
    const float* LG = (const float*)(ws + WS_LOGITS); int* SEL = (int*)(ws + WS_TOKSEL); float* TW = (float*)(ws + WS_TOKW);
    const float rb = in.router_bias[lane];
    float lg[4];
    for (int tok = t0 + wave, i4 = 0; tok < t0 + 256; tok += NWAVES, i4 = (i4 + 1) & 3) {
        if (i4 == 0) {
#pragma unroll
            for (int u = 0; u < 4; ++u) lg[u] = LG[(size_t)(tok + u * NWAVES < t0 + 256 ? tok + u * NWAVES : tok) * 64 + lane]; }
        const float lgc = i4 == 0 ? lg[0] : (i4 == 1 ? lg[1] : (i4 == 2 ? lg[2] : lg[3]));
        const float s = 1.0f / (1.0f + __expf(-lgc)), ss = s + rb;
        int rk8 = 0;
#pragma unroll
        for (int j = 0; j < 8; ++j) { const float o = __shfl(ss, (lane & ~7) + j); rk8 += (o > ss || (o == ss && j < (lane & 7))) ? 1 : 0; }
        float gsum = rk8 < 2 ? ss : 0.f; gsum += __shfl_xor(gsum, 1); gsum += __shfl_xor(gsum, 2); gsum += __shfl_xor(gsum, 4);
        int rkg = 0; const int g = lane >> 3;
#pragma unroll
        for (int j = 0; j < 8; ++j) { const float o = __shfl(gsum, 8 * j); rkg += (o > gsum || (o == gsum && j < g)) ? 1 : 0; }
        const float msk = rkg < 4 ? ss : -INFINITY;
        int rk = 0;
#pragma unroll
        for (int j = 0; j < 64; ++j) { const float o = __builtin_bit_cast(float, __builtin_amdgcn_readlane(__builtin_bit_cast(int, msk), j)); rk += (o > msk || (o == msk && j < lane)) ? 1 : 0; }
        const bool sel = rk < 8;
        const float wsum = wave_sum(sel ? s : 0.f);
        if (sel) { SEL[(size_t)tok * 8 + rk] = lane; TW[(size_t)tok * 8 + rk] = s * 2.5f / wsum; ++mycount; }
    }
}

__device__ __forceinline__ void p16_fill(unsigned char* ws, LAS unsigned char* lds, int vcu, int G) {
    int tid = threadIdx.x; asm volatile("" : "+v"(tid));
    LAS unsigned* hist = (LAS unsigned*)lds; LAS unsigned* basev = hist + 64; LAS unsigned* pstart = hist + 128; LAS unsigned* cnts = hist + 256;
    unsigned* CTL = (unsigned*)(ws + WS_CTL); const int* SEL = (const int*)(ws + WS_TOKSEL); const float* TW = (const float*)(ws + WS_TOKW);
    int* LT = (int*)(ws + WS_LISTTOK); float* LW = (float*)(ws + WS_LISTW); int* TE = (int*)(ws + WS_TILEE); int* LP = (int*)(ws + WS_LISTP);
    if (tid < 64) { hist[tid] = 0u; cnts[tid] = CTL[CW_CNT + tid]; }
    __syncthreads();
    if (tid == 0) { unsigned acc = 0; for (int e = 0; e < 64; ++e) { pstart[e] = acc; acc += (cnts[e] + 255u) & ~255u; } pstart[64] = acc; }
    __syncthreads();
    if (vcu == 0) {
        if (tid == 0) CTL[CW_NT] = pstart[64] >> 8;
        for (int e = tid >> 3; e < 64; e += 64) { for (unsigned p = pstart[e] + cnts[e] + (tid & 7); p < pstart[e + 1]; p += 8) { LT[p] = 0; LW[p] = 0.f; LP[p] = -1; } }
        for (unsigned t = tid; t < (pstart[64] >> 8); t += NTHR) { int e = 0; for (int q = 0; q < 64; ++q) if ((t << 8) >= pstart[q]) e = q; TE[t] = e; }
    }
    const int per = (NTOK + G - 1) / G, t0 = vcu * per, t1 = (t0 + per < NTOK) ? t0 + per : NTOK;
    for (int p = t0 * 8 + tid; p < t1 * 8; p += NTHR) lds_add(&hist[SEL[p]], 1u);
    __syncthreads();
    if (tid < 64) { basev[tid] = hist[tid] ? atomicAdd(CTL + CW_CUR + tid, hist[tid]) : 0u; }
    __syncthreads();
    if (tid < 64) hist[tid] = 0u;
    __syncthreads();
    for (int p = t0 * 8 + tid; p < t1 * 8; p += NTHR) { const int e = SEL[p]; const unsigned slot = pstart[e] + basev[e] + lds_add(&hist[e], 1u); LT[slot] = p >> 3; LW[slot] = TW[p]; LP[slot] = p; }
    __syncthreads();
}

__device__ __forceinline__ void p19_final(const In& in, unsigned char* ws, float* out, int vcu, int G) {
    const int tid = threadIdx.x, lane = tid & 63, wave = __builtin_amdgcn_readfirstlane(tid >> 6);
    const int gw = vcu * NWAVES + wave, NGW = G * NWAVES;
    const float* MOD = (const float*)(ws + WS_CTL) + CW_MOD;
    for (int mrow = gw; mrow < NTOK; mrow += NGW) { const int b = mrow >> 13;
        const u32x2* yr = (const u32x2*)((const bf16*)(ws + WS_Y2) + (size_t)mrow * DM) + lane; f32x4 v[4]; float s2 = 0.f;
#pragma unroll
        for (int j = 0; j < 4; ++j) { const u32x2 w = yr[64 * j]; v[j] = (f32x4){bf_lo(w.x), bf_hi(w.x), bf_lo(w.y), bf_hi(w.y)}; }
        f32x4* o4 = (f32x4*)(out + (size_t)mrow * DM) + lane; f32x4 x1v[4];
#pragma unroll
        for (int j = 0; j < 4; ++j) x1v[j] = o4[64 * j];
        { unsigned sv[8][4];
#pragma unroll
          for (int k = 0; k < 8; ++k) { const unsigned* sr = (const unsigned*)slot_row(ws, mrow * 8 + k) + lane;
#pragma unroll
              for (int j = 0; j < 4; ++j) sv[k][j] = sr[64 * j]; }
#pragma unroll
          for (int j = 0; j < 4; ++j) { f32x4 rs = {0.f, 0.f, 0.f, 0.f};
#pragma unroll
              for (int k = 0; k < 8; ++k) { rs[0] += __builtin_amdgcn_cvt_f32_fp8((int)sv[k][j], 0); rs[1] += __builtin_amdgcn_cvt_f32_fp8((int)sv[k][j], 1); rs[2] += __builtin_amdgcn_cvt_f32_fp8((int)sv[k][j], 2); rs[3] += __builtin_amdgcn_cvt_f32_fp8((int)sv[k][j], 3); }
              v[j] = v[j] + rs * 0.125f; } }
#pragma unroll
        for (int j = 0; j < 4; ++j) s2 += (v[j].x * v[j].x + v[j].y * v[j].y) + (v[j].z * v[j].z + v[j].w * v[j].w);
        const float rstd = 1.0f / sqrtf(wave_sum(s2) * (1.f / DM) + EPSN);
#pragma unroll
        for (int j = 0; j < 4; ++j) { const int col = 256 * j + 4 * lane; const f32x4 g = *(const f32x4*)(in.norm_gain + 3072 + col), gf = *(const f32x4*)(MOD + b * 6144 + 5120 + col);
            o4[64 * j] = x1v[j] + gf * (v[j] * rstd * g); } }
}

__device__ __forceinline__ int crow(int r, int hi) { return (r & 3) + 8 * (r >> 2) + 4 * hi; }
constexpr int IX_QS = 0, IX_H1 = 69632, IX_H2 = 102400, IX_TAB = 135168, IX_WL = 138240;

__device__ __forceinline__ void lds_inc(LAS unsigned* p) { (void)__hip_atomic_fetch_add(p, 1u, __ATOMIC_RELAXED, __HIP_MEMORY_SCOPE_WORKGROUP); }
__device__ __forceinline__ unsigned suffix_incl(unsigned v, int lane) {
#pragma unroll
    for (int off = 1; off < 64; off <<= 1) { const unsigned t = __shfl_down(v, off); if (lane + off < 64) v += t; }
    return v;
}
__device__ __forceinline__ void find_bins(LAS unsigned* hist, int wave, int lane, const int (&need)[4], LAS int* out_bin, LAS int* out_above) {
#pragma unroll
    for (int qq = 0; qq < 4; ++qq) { const int q = wave * 4 + qq;
        unsigned cj[4]; unsigned tot = 0;
#pragma unroll
        for (int j = 0; j < 4; ++j) { cj[j] = hist[(4 * lane + j) * 32 + q]; tot += cj[j]; }
        unsigned cum = suffix_incl(tot, lane) - tot;
#pragma unroll
        for (int j = 3; j >= 0; --j) { if ((int)cum < need[qq] && (int)(cum + cj[j]) >= need[qq]) { out_bin[q] = 4 * lane + j; out_above[q] = (int)cum; } cum += cj[j]; } }
}

__device__ __forceinline__ void p8_indexer(unsigned char* ws, LAS unsigned char* lds, int vcu, int G) {
    const int wave = __builtin_amdgcn_readfirstlane(threadIdx.x >> 6);
    const bf16* QI = (const bf16*)(ws + WS_QI); const bf16* KI = (const bf16*)(ws + WS_KI); const float* WI = (const float*)(ws + WS_WI);
    unsigned* SCR = (unsigned*)(ws + WS_SCR) + (size_t)vcu * 131072;
    LAS unsigned* H1 = (LAS unsigned*)(lds + IX_H1); LAS unsigned* H2 = (LAS unsigned*)(lds + IX_H2);
    LAS int* TB1 = (LAS int*)(lds + IX_TAB); LAS int* TAB = TB1 + 32; LAS int* TTHR = TB1 + 64; LAS int* TN3 = TB1 + 96; LAS int* TAB2 = TB1 + 128; LAS int* TV = TB1 + 160; LAS unsigned* CNT = (LAS unsigned*)(TB1 + 192);
    const int nrounds = (1024 + G - 1) / G;
    for (int rnd = 0; rnd < nrounds; ++rnd) {
        int tid = threadIdx.x; asm volatile("" : "+v"(tid));
        const int lane = tid & 63, c = lane & 31, hi = lane >> 5;
        const int ui = rnd * G + ((rnd & 1) ? (G - 1 - vcu) : vcu);
        if (ui >= 1024) continue;
        const int qg = 255 - (ui >> 2), b = ui & 3, t0 = qg * 32; const size_t rowbase = (size_t)b * SEQ;
        unsigned* MK = (unsigned*)(ws + WS_MASK) + ((size_t)(b * 256 + qg) * 128) * 64;
        if (qg < 8) {
            if (wave == 0) {
                for (int j = 0; j < 4; ++j) { unsigned W = 0u;
#pragma unroll
                    for (int r = 0; r < 16; ++r) { const int k0 = 64 * j + crow(r, hi), k1 = k0 + 32; W |= (k0 <= t0 + c ? 1u : 0u) << r; W |= (k1 <= t0 + c ? 1u : 0u) << (16 + r); }
                    unsigned ow = 0u;
#pragma unroll
                    for (int m = 0; m < 32; ++m) { const unsigned long long B = __ballot((W >> m) & 1u); const unsigned v = (lane & 1) ? (unsigned)(B >> 32) : (unsigned)B; ow = ((lane >> 1) == m) ? v : ow; }
                    MK[j * 64 + lane] = ow; }
            }
            continue;
        }
#pragma unroll
        for (int i = 0; i < 8; ++i) { const int j = tid + 512 * i, n = j & 31, rest = j >> 5, g = rest & 1, ks = (rest >> 1) & 3, h = rest >> 3;
            const u32x4 v = *(const u32x4*)(QI + (rowbase + t0 + n) * 1024 + h * 64 + ks * 16 + g * 8);
            *(LAS u32x4*)(lds + IX_QS + ((h * 4 + ks) * 2 + g) * 512 + n * 16) = v; }
#pragma unroll
        for (int i = 0; i < 32; ++i) H1[tid + 512 * i] = 0u;
        ((LAS float*)(lds + IX_WL))[tid] = WI[(rowbase + t0 + (tid & 31)) * 16 + (tid >> 5)];
        __syncthreads();
        { const int n = tid & 31, d0 = (tid >> 5) * 4, ks = d0 >> 4, g = (d0 >> 3) & 1;
            float a0 = 0.f, a1 = 0.f, a2 = 0.f, a3 = 0.f;
#pragma unroll
            for (int h = 0; h < 16; ++h) { const float w = WI[(rowbase + t0 + n) * 16 + h]; const u32x2 qv = *(const LAS u32x2*)(lds + IX_QS + ((h * 4 + ks) * 2 + g) * 512 + n * 16 + (d0 & 7) * 2);
                a0 += w * bf_lo(qv.x); a1 += w * bf_hi(qv.x); a2 += w * bf_lo(qv.y); a3 += w * bf_hi(qv.y); }
            u32x2 o; o.x = cvt_pk_bf16(a0, a1); o.y = cvt_pk_bf16(a2, a3);
            *(LAS u32x2*)(lds + IX_QS + ((16 * 4 + ks) * 2 + g) * 512 + n * 16 + (d0 & 7) * 2) = o; }
        __syncthreads();
        const int ngroups = (qg >> 2) + 1;
        for (int it = wave; it < ngroups; it += 8) {
            bf16x8 kf[4][4];
#pragma unroll
            for (int tile = 0; tile < 4; ++tile) { const int kt = 4 * it + tile, ktc = kt < qg ? kt : qg;
#pragma unroll
                for (int ks = 0; ks < 4; ++ks) kf[tile][ks] = *(const bf16x8*)(KI + (rowbase + 32 * ktc + c) * 64 + ks * 16 + hi * 8); }
            f32x16 sc[4];
#pragma unroll
            for (int tile = 0; tile < 4; ++tile)
#pragma unroll
                for (int r = 0; r < 16; ++r) sc[tile][r] = 0.f;
            bf16x8 bq[2][4]; f32x16 av[2]; float wq[2];
#define IX_LDQ(h_) do { _Pragma("unroll") for (int ks = 0; ks < 4; ++ks) bq[(h_) & 1][ks] = *(const LAS bf16x8*)(lds + IX_QS + (((h_) * 4 + ks) * 2 + hi) * 512 + c * 16); \
            wq[(h_) & 1] = ((const LAS float*)(lds + IX_WL))[((h_) & 15) * 32 + c]; } while (0)
            IX_LDQ(0);
#define IX_STEP(st) do { constexpr int h = (st) >> 1, pair = (st) & 1; \
                if (pair == 0 && h + 1 < 17) IX_LDQ(h + 1); \
                _Pragma("unroll") for (int r = 0; r < 16; ++r) { av[0][r] = 0.f; av[1][r] = 0.f; } \
                _Pragma("unroll") for (int ks = 0; ks < 4; ++ks) { av[0] = __builtin_amdgcn_mfma_f32_32x32x16_bf16(kf[2 * pair][ks], bq[h & 1][ks], av[0], 0, 0, 0); \
                    av[1] = __builtin_amdgcn_mfma_f32_32x32x16_bf16(kf[2 * pair + 1][ks], bq[h & 1][ks], av[1], 0, 0, 0); } \
                if (h < 16) { _Pragma("unroll") for (int r = 0; r < 16; ++r) { sc[2 * pair][r] = __builtin_fmaf(__builtin_fabsf(av[0][r]), wq[h & 1], sc[2 * pair][r]); sc[2 * pair + 1][r] = __builtin_fmaf(__builtin_fabsf(av[1][r]), wq[h & 1], sc[2 * pair + 1][r]); } } \
                else { _Pragma("unroll") for (int r = 0; r < 16; ++r) { sc[2 * pair][r] += av[0][r]; sc[2 * pair + 1][r] += av[1][r]; } } \
                __builtin_amdgcn_sched_barrier(0); } while (0)
#define IX_STEP2(s) IX_STEP((s)); IX_STEP((s) + 1)
            IX_STEP2(0); IX_STEP2(2); IX_STEP2(4); IX_STEP2(6); IX_STEP2(8); IX_STEP2(10); IX_STEP2(12); IX_STEP2(14); IX_STEP2(16);
            IX_STEP2(18); IX_STEP2(20); IX_STEP2(22); IX_STEP2(24); IX_STEP2(26); IX_STEP2(28); IX_STEP2(30); IX_STEP2(32);
#undef IX_STEP2
#undef IX_STEP
#undef IX_LDQ
            if (4 * it + 3 < qg) {
                asm volatile("; keys of a group below the diagonal" ::: "memory");
#pragma unroll
            for (int tile = 0; tile < 4; ++tile) { const int kt = 4 * it + tile;
#pragma unroll
                for (int rq = 0; rq < 2; ++rq) { u32x4 pq;
#pragma unroll
                    for (int j = 0; j < 4; ++j) { const int rp = 4 * rq + j, r0 = 2 * rp;
                        unsigned p = __builtin_bit_cast(unsigned, __builtin_amdgcn_cvt_pkrtz(sc[tile][r0], sc[tile][r0 + 1]));
                        p ^= 0x80008000u | __builtin_bit_cast(unsigned, __builtin_bit_cast(s16x2, p) >> (short)15);
                        lds_inc(H1 + ((p >> 8) & 255u) * 32 + c); lds_inc(H1 + (p >> 24) * 32 + c);
                        pq[j] = p; }
                    *(u32x4*)(SCR + ((size_t)((it * 8 + tile * 2 + rq) * 64 + lane)) * 4) = pq; } }
            } else {
                asm volatile("; keys of the diagonal group" ::: "memory");
#pragma unroll
            for (int tile = 0; tile < 4; ++tile) { const int kt = 4 * it + tile;
#pragma unroll
                for (int rq = 0; rq < 2; ++rq) { u32x4 pq;
#pragma unroll
                    for (int j = 0; j < 4; ++j) { const int rp = 4 * rq + j, r0 = 2 * rp;
                        unsigned p = __builtin_bit_cast(unsigned, __builtin_amdgcn_cvt_pkrtz(sc[tile][r0], sc[tile][r0 + 1]));
                        p ^= 0x80008000u | __builtin_bit_cast(unsigned, __builtin_bit_cast(s16x2, p) >> (short)15);
                        if (kt > qg) p = 0u;
                        else if (kt == qg) { if (crow(r0, hi) > c) p &= 0xffff0000u; if (crow(r0 + 1, hi) > c) p &= 0x0000ffffu; }
                        lds_inc(H1 + ((p >> 8) & 255u) * 32 + c); lds_inc(H1 + (p >> 24) * 32 + c);
                        pq[j] = p; }
                    *(u32x4*)(SCR + ((size_t)((it * 8 + tile * 2 + rq) * 64 + lane)) * 4) = pq; } }
            }
        }
        __syncthreads();
        int need[4];
#pragma unroll
        for (int qq = 0; qq < 4; ++qq) { const int nn = t0 + wave * 4 + qq + 1; need[qq] = nn < 256 ? nn : 256; }
        find_bins(H1, wave, lane, need, TB1, TAB);
        asm volatile("s_waitcnt vmcnt(0)" ::: "memory");
        __syncthreads();
        const unsigned b1 = (unsigned)TB1[c];
        for (int it = wave; it < ngroups; it += 8) { unsigned pv[32];
#pragma unroll
            for (int q4 = 0; q4 < 8; ++q4) { const u32x4 v4 = *(const u32x4*)(SCR + ((size_t)((it * 8 + q4) * 64 + lane)) * 4); pv[4 * q4] = v4.x; pv[4 * q4 + 1] = v4.y; pv[4 * q4 + 2] = v4.z; pv[4 * q4 + 3] = v4.w; }
#pragma unroll
            for (int s = 0; s < 32; ++s) { const unsigned p = pv[s];
                if (((p >> 8) & 255u) == b1) lds_inc(H2 + (p & 255u) * 32 + c);
                if ((p >> 24) == b1) lds_inc(H2 + ((p >> 16) & 255u) * 32 + c); } }
        __syncthreads();
        int need2[4];
#pragma unroll
        for (int qq = 0; qq < 4; ++qq) need2[qq] = need[qq] - TAB[wave * 4 + qq];
        find_bins(H2, wave, lane, need2, TV, TAB2);
        __syncthreads();
        const unsigned thr = (b1 << 8) | (unsigned)TV[c];
        const int needc = (t0 + c + 1) < 256 ? (t0 + c + 1) : 256;
        const int ties_take = needc - TAB[c] - TAB2[c];
        unsigned cnt = 0;
        for (int it = wave; it < ngroups; it += 8) { unsigned pv[32];
#pragma unroll
            for (int q4 = 0; q4 < 8; ++q4) { const u32x4 v4 = *(const u32x4*)(SCR + ((size_t)((it * 8 + q4) * 64 + lane)) * 4); pv[4 * q4] = v4.x; pv[4 * q4 + 1] = v4.y; pv[4 * q4 + 2] = v4.z; pv[4 * q4 + 3] = v4.w; }
#pragma unroll
            for (int s = 0; s < 32; ++s) { const unsigned p = pv[s]; cnt += ((p & 0xffffu) == thr) ? 1u : 0u; cnt += ((p >> 16) == thr) ? 1u : 0u; } }
        CNT[wave * 64 + lane] = cnt;
        __syncthreads();
        int rank = 0;
        for (int w2 = 0; w2 < wave; ++w2) rank += (int)(CNT[w2 * 64 + c] + CNT[w2 * 64 + 32 + c]);
        if (hi) rank += (int)CNT[wave * 64 + c];
        for (int it = wave; it < ngroups; it += 8) { unsigned pv[32];
#pragma unroll
            for (int q4 = 0; q4 < 8; ++q4) { const u32x4 v4 = *(const u32x4*)(SCR + ((size_t)((it * 8 + q4) * 64 + lane)) * 4); pv[4 * q4] = v4.x; pv[4 * q4 + 1] = v4.y; pv[4 * q4 + 2] = v4.z; pv[4 * q4 + 3] = v4.w; }
            unsigned W[2] = {0u, 0u};
#pragma unroll
            for (int tile = 0; tile < 4; ++tile) {
#pragma unroll
                for (int rp = 0; rp < 8; ++rp) { const unsigned p = pv[tile * 8 + rp];
                    const unsigned k0 = p & 0xffffu, k1 = p >> 16;
                    const bool s0 = k0 > thr || (k0 == thr && rank < ties_take); if (k0 == thr) ++rank;
                    const bool s1 = k1 > thr || (k1 == thr && rank < ties_take); if (k1 == thr) ++rank;
                    const unsigned long long B0 = __ballot(s0), B1 = __ballot(s1); const int m0 = (tile & 1) * 16 + 2 * rp;
                    const unsigned v0 = (lane & 1) ? (unsigned)(B0 >> 32) : (unsigned)B0, v1 = (lane & 1) ? (unsigned)(B1 >> 32) : (unsigned)B1;
                    W[tile >> 1] = ((lane >> 1) == m0) ? v0 : (((lane >> 1) == m0 + 1) ? v1 : W[tile >> 1]); } }
            MK[(2 * it) * 64 + lane] = W[0]; MK[(2 * it + 1) * 64 + lane] = W[1]; }
        __syncthreads();
    }
}

constexpr int AT_K = 0, AT_TB = 8192, AT_V = 4 * 8192, AT_BIAS = 8 * 8192;
__device__ __forceinline__ unsigned pk4_fp8(float a, float b, float c, float d) { int w = __builtin_amdgcn_cvt_pk_fp8_f32(a, b, 0, false); w = __builtin_amdgcn_cvt_pk_fp8_f32(c, d, w, true); return (unsigned)w; }
__device__ __forceinline__ unsigned pk4_fp8t(float a, float b, float c, float d) { int w = __builtin_amdgcn_cvt_pk_fp8_f32(a, b, __builtin_bit_cast(int, a), false); w = __builtin_amdgcn_cvt_pk_fp8_f32(c, d, w, true); return (unsigned)w; }
__device__ __forceinline__ pg8::i32x8 ld_frag8(const LAS unsigned char* base, int off) {
    const u32x4 a = *(const LAS u32x4*)(base + off), b = *(const LAS u32x4*)(base + (off ^ 16)); return (pg8::i32x8){(int)a.x, (int)a.y, (int)a.z, (int)a.w, (int)b.x, (int)b.y, (int)b.z, (int)b.w}; }
#define MFMA8(A, B, C) __builtin_amdgcn_mfma_scale_f32_32x32x64_f8f6f4(A, B, C, 0, 0, 0, 0, 0, 0)

__device__ __forceinline__ void p9_attention(const In& in, unsigned char* ws, LAS unsigned char* lds, int vcu, int G) {
    const int tid = threadIdx.x, lane = tid & 63, wave = __builtin_amdgcn_readfirstlane(tid >> 6), c = lane & 31, hi = lane >> 5;
    const unsigned char* Q = ws + WS_Q; const unsigned char* Kp = ws + WS_K; const unsigned char* VT = ws + WS_VT; unsigned char* YA = ws + WS_YATT;
    const unsigned* MASK = (const unsigned*)(ws + WS_MASK);
    LAS float* BIAS = (LAS float*)(lds + AT_BIAS);
    const float NEG = -INFINITY;
    const int nrounds = (1024 + G - 1) / G;
    for (int rnd = 0; rnd < nrounds; ++rnd) {
        int qb, bh;
        if (G == 256) {
            const int xcd = vcu >> 5, w5 = vcu & 31, p = w5 & 15; bh = (rnd >> 1) * 16 + xcd * 2 + (w5 >> 4); qb = (rnd & 1) ? p : 31 - p;
        } else { const int ui = rnd * G + ((rnd & 1) ? (G - 1 - vcu) : vcu); if (ui >= 1024) continue; qb = 31 - (ui >> 5); bh = ui & 31; }
        const int b = bh >> 3, h = bh & 7;
        __syncthreads();
        if (tid < 128) { int bk = tid; if (tid >= 16) { bk = 16 + (int)(__log2f((float)tid * 0.0625f) * 5.3333333f); bk = bk > 31 ? 31 : bk; } BIAS[tid] = LOG2E * in.rel_bias[bk * 8 + h]; }
        const float cfar = LOG2E * in.rel_bias[31 * 8 + h];
        const int tq0 = 256 * qb + 32 * wave, t = tq0 + c, qg = tq0 >> 5;
        pg8::i32x8 qf[2];
#pragma unroll
        for (int ks = 0; ks < 2; ++ks) { const u32x4* qp = (const u32x4*)(Q + ((size_t)(b * SEQ + t)) * 1024 + h * 128 + ks * 64 + hi * 32); const u32x4 x = qp[0], y = qp[1];
            qf[ks] = (pg8::i32x8){(int)x.x, (int)x.y, (int)x.z, (int)x.w, (int)y.x, (int)y.y, (int)y.z, (int)y.w}; }
        f32x16 oacc[4];
#pragma unroll
        for (int db = 0; db < 4; ++db)
#pragma unroll
            for (int r = 0; r < 16; ++r) oacc[db][r] = 0.f;
        float m_run = -1e30f, l_run = 0.f;
        const int ntile = 4 * (qb + 1);
        const int krow_ = 8 * wave + (lane >> 3), vrow_ = 16 * wave + (lane >> 2);
        const unsigned char* ksrc = Kp + ((size_t)(b * SEQ + krow_)) * 1024 + h * 128 + (((lane & 7) ^ ((krow_ >> 1) & 7)) * 16);
        const unsigned char* vsrc = VT + ((size_t)(h * 128 + vrow_)) * NTOK + b * SEQ + (((lane & 3) ^ ((vrow_ >> 2) & 3)) * 16);
#define AT_DMA(j, buf) do { \
            __builtin_amdgcn_global_load_lds((const unsigned*)(ksrc + (size_t)(64 * (j)) * 1024), (LAS unsigned*)(lds + AT_K + (buf) * AT_TB + wave * 1024), 16, 0, 0); \
            __builtin_amdgcn_global_load_lds((const unsigned*)(vsrc + 64 * (j)), (LAS unsigned*)(lds + AT_V + (buf) * AT_TB + wave * 1024), 16, 0, 0); } while (0)
        const unsigned long long* mrow = (const unsigned long long*)(MASK + (((size_t)(b * 256 + qg)) * 128) * 64);
        u64x8 mk0, mk1, mk2, mk3;
#define AT_MLOAD(j, dep) asm volatile("s_load_dwordx16 %0, %4, 0x0\n\ts_load_dwordx16 %1, %4, 0x40\n\ts_load_dwordx16 %2, %4, 0x80\n\ts_load_dwordx16 %3, %4, 0xc0" \
            : "=&s"(mk0), "=&s"(mk1), "=&s"(mk2), "=&s"(mk3) : "s"(mrow + (size_t)(j) * 32), "v"(dep) : "memory")
        AT_MLOAD(0, tid);
#pragma unroll
        for (int ks = 0; ks < 2; ++ks) asm volatile("" :: "v"(qf[ks]));
        asm volatile("s_waitcnt vmcnt(0)" ::: "memory");
        AT_DMA(0, 0); AT_DMA(1, 1); AT_DMA(2, 2);
        asm volatile("s_waitcnt vmcnt(2)" ::: "memory");
        asm volatile("s_waitcnt lgkmcnt(0)" : "+s"(mk0), "+s"(mk1), "+s"(mk2), "+s"(mk3) :: "memory");
        __builtin_amdgcn_s_barrier();
        const int koff = c * 128 + (((2 * hi) ^ ((c >> 1) & 7)) << 4), voff = c * 64 + (((2 * hi) ^ ((c >> 2) & 3)) << 4);
        const int jw = (tq0 + 31) >> 6;
        pg8::i32x8 kf[4];
        kf[0] = ld_frag8(lds + AT_K, koff); kf[1] = ld_frag8(lds + AT_K, koff ^ 64); kf[2] = ld_frag8(lds + AT_K + 4096, koff); kf[3] = ld_frag8(lds + AT_K + 4096, koff ^ 64);
        for (int j = 0; j < ntile; ++j) {
            const int buf = j & 3;
            if (j <= jw) {
                f32x16 p0, p1;
                {
                    const f32x16 z = {0.f, 0.f, 0.f, 0.f, 0.f, 0.f, 0.f, 0.f, 0.f, 0.f, 0.f, 0.f, 0.f, 0.f, 0.f, 0.f};
                    p0 = MFMA8(kf[0], qf[0], z); p1 = MFMA8(kf[2], qf[0], z); p0 = MFMA8(kf[1], qf[1], p0); p1 = MFMA8(kf[3], qf[1], p1);
                }
                pg8::i32x8 vf[4];
                { const LAS unsigned char* vb = lds + AT_V + buf * AT_TB;
#pragma unroll
                  for (int db = 0; db < 4; ++db) vf[db] = ld_frag8(vb + db * 2048, voff); }
                if (j < jw) { const LAS unsigned char* kn = lds + AT_K + ((j + 1) & 3) * AT_TB;
                    kf[0] = ld_frag8(kn, koff); kf[1] = ld_frag8(kn, koff ^ 64); kf[2] = ld_frag8(kn + 4096, koff); kf[3] = ld_frag8(kn + 4096, koff ^ 64); }
                const int dmin = tq0 - (64 * j + 63);
                float boff = cfar;
                if (dmin < 113) { boff = 0.f;
#pragma unroll
                    for (int r = 0; r < 16; ++r) { int d0 = t - (64 * j + crow(r, hi)), d1 = d0 - 32; d0 = d0 < 0 ? 0 : (d0 > 127 ? 127 : d0); d1 = d1 < 0 ? 0 : (d1 > 127 ? 127 : d1); p0[r] += BIAS[d0]; p1[r] += BIAS[d1]; }
                }
                {
                    const float touch = p0[0] + p1[0];
#define AT_SELM(P, r, M) do { float o_; asm("v_cndmask_b32_e64 %0, %1, %2, %3" : "=v"(o_) : "v"(NEG), "v"(P[r]), "s"(M), "v"(touch)); P[r] = o_; } while (0)
#pragma unroll
                    for (int r = 0; r < 8; ++r) { AT_SELM(p0, r, mk0[r]); AT_SELM(p0, 8 + r, mk1[r]); AT_SELM(p1, r, mk2[r]); AT_SELM(p1, 8 + r, mk3[r]); }
#undef AT_SELM
                }
                float mx = fmaxf(fmaxf(p0[0], p0[1]), p1[0]);
#pragma unroll
                for (int r = 2; r < 16; r += 2) mx = fmaxf(fmaxf(mx, p0[r]), p0[r + 1]);
#pragma unroll
                for (int r = 1; r < 15; r += 2) mx = fmaxf(fmaxf(mx, p1[r]), p1[r + 1]);
                mx = fmaxf(mx, p1[15]);
                mx = fmaxf(mx, __shfl_xor(mx, 32)) + boff;
                AT_MLOAD(j + 1 < 128 ? j + 1 : 127, mx);
                const float m_new = (mx > m_run + 2.0f) ? mx : m_run, alpha = fast_exp2(m_run - m_new); m_run = m_new;
                const float sub = m_new - boff - 6.0f;
                const f32x2 ns2 = {-sub, -sub};
                f32x2 s2a = {0.f, 0.f}, s2b = {0.f, 0.f}, q[16];
#pragma unroll
                for (int i = 0; i < 8; ++i) { q[i] = (f32x2){p0[2 * i], p0[2 * i + 1]}; q[8 + i] = (f32x2){p1[2 * i], p1[2 * i + 1]}; }
#pragma unroll
                for (int i = 0; i < 16; i += 2) { f32x2 u = q[i], v = q[i + 1];
                    u = u + ns2; v = v + ns2;
                    u.x = fast_exp2(u.x); u.y = fast_exp2(u.y); v.x = fast_exp2(v.x); v.y = fast_exp2(v.y);
                    s2a = s2a + u; s2b = s2b + v;
                    q[i] = u; q[i + 1] = v; }
                l_run = l_run * alpha + ((s2a.x + s2b.x) + (s2a.y + s2b.y));
                if (!__all(alpha == 1.0f)) {
#pragma unroll
                    for (int db = 0; db < 4; ++db)
#pragma unroll
                        for (int r = 0; r < 16; ++r) oacc[db][r] *= alpha; }
                pg8::i32x8 pb;
#pragma unroll
                for (int i = 0; i < 4; ++i) { const unsigned a = pk4_fp8t(q[2 * i].x, q[2 * i].y, q[2 * i + 1].x, q[2 * i + 1].y), bq = pk4_fp8t(q[8 + 2 * i].x, q[8 + 2 * i].y, q[9 + 2 * i].x, q[9 + 2 * i].y);
                    const auto sw = __builtin_amdgcn_permlane32_swap(a, bq, false, false); pb[2 * i] = (int)sw[0]; pb[2 * i + 1] = (int)sw[1]; }
#pragma unroll
                for (int db = 0; db < 4; ++db) oacc[db] = MFMA8(vf[db], pb, oacc[db]);
            }
            if (j + 3 < ntile) AT_DMA(j + 3, (j + 3) & 3);
            if (j + 3 < ntile) asm volatile("s_waitcnt vmcnt(2)" ::: "memory"); else asm volatile("s_waitcnt vmcnt(0)" ::: "memory");
            asm volatile("s_waitcnt lgkmcnt(0)" ::: "memory");
            __builtin_amdgcn_s_barrier();
        }
        const float l = l_run + __shfl_xor(l_run, 32), inv = 1.0f / l;
        unsigned char* yrow = YA + ((size_t)(b * SEQ + t)) * 1024 + h * 128 + 4 * hi;
#pragma unroll
        for (int db = 0; db < 4; ++db)
#pragma unroll
            for (int rg = 0; rg < 4; ++rg) *(unsigned*)(yrow + 32 * db + 8 * rg) = pk4_fp8(clamp_e4m3(oacc[db][4 * rg] * inv), clamp_e4m3(oacc[db][4 * rg + 1] * inv), clamp_e4m3(oacc[db][4 * rg + 2] * inv), clamp_e4m3(oacc[db][4 * rg + 3] * inv));
#undef AT_DMA
#undef AT_MLOAD
    }
}

struct Args { In in; float* out; unsigned char* ws; int ph_lo, ph_hi; };
constexpr int N_PHASES = 20;

__global__ void __launch_bounds__(NTHR, 2) mk_fwd(Args args) {
    extern __shared__ __attribute__((aligned(16))) unsigned char lds_raw[];
    LAS unsigned char* lds = (LAS unsigned char*)lds_raw;
    const int tid = threadIdx.x;
    const int G = gridDim.x; int vcu; { const int bx = blockIdx.x; vcu = (G % 8 == 0) ? (bx % 8) * (G / 8) + bx / 8 : bx; }
    unsigned char* ws = args.ws; const In& in = args.in;
    volatile LAS unsigned* MISC = (volatile LAS unsigned*)(lds + LDSCTL_OFF);
    for (int u = tid; u < (LDS_BYTES - LDSCTL_OFF) / 4; u += NTHR) ((LAS unsigned*)(lds + LDSCTL_OFF))[u] = 0u;
    __syncthreads();
    XcdBarrier bar = xcd_barrier_post((unsigned*)(ws + WS_CTL) + CW_BAR, MISC + 8);
    const int lo = args.ph_lo, hi = args.ph_hi;
#ifdef ONLY
#define IN(k) ((k) == ONLY && lo <= (k) && (k) < hi)
#else
#define IN(k) (lo <= (k) && (k) < hi)
#endif
#define SEAM(k) do { if (IN(k) && IN((k) + 1)) xcd_barrier(bar); } while (0)
    const int cid = (int)blockIdx.x;

    if (IN(0)) { p0_prologue(in, ws, lds, vcu, G); } SEAM(0);
    if (IN(1)) { p1_norm_rows(in, ws, vcu, G); } SEAM(1);
    if (IN(2)) {
        pg8::DenseOrder S; S.init(ws + WS_H, ws + WS_WIN_T, NTOK, 2048, 1024, 1024, G, cid);
        EpiSplitBf16<0, 1> E{(bf16*)(ws + WS_URNN), (bf16*)(ws + WS_GGATE), 1024, 1024, 1.0f, 1.0f};
        pg8::gemm_phase<EpiSplitBf16<0, 1>, pg8::DenseOrder, true, true>(lds, pg8::Gemm{1024, 1024, 1024}, S, E);
    } SEAM(2);
    if (IN(3)) { p3_conv(in, ws, vcu, G); } SEAM(3);
    if (IN(4)) {
        pg8::DenseOrder S; S.init(ws + WS_XC, ws + WS_WG_T, NTOK, 2048, 1024, 256, G, cid); S.a_sh = 1; S.a_mul = 256 * 2;
        EpiGate E{(const bf16*)(ws + WS_XC), (bf16*)(ws + WS_LOGA), (bf16*)(ws + WS_BB), in.b_rg_a, in.b_rg_x, (const float*)(ws + WS_SPL)};
        pg8::gemm_phase<EpiGate, pg8::DenseOrder, true, true>(lds, pg8::Gemm{1024, 256, 256}, S, E);
    } SEAM(4);
    if (IN(5)) { p5_scan_local(ws, vcu, G); } SEAM(5);
    if (IN(6)) {
        p7_scan_final(ws, vcu, G);
        pg8::DenseOrder S; S.init(ws + WS_H, ws + WS_WIN_T + (size_t)C_QI * 1024 * 2, NTOK, 1280, 1024, 1024, G, cid);
        EpiIdx E{(bf16*)(ws + WS_QI), (bf16*)(ws + WS_KI), (float*)(ws + WS_WI)};
        pg8::gemm_phase<EpiIdx, pg8::DenseOrder, true, true>(lds, pg8::Gemm{1024, 1024, 1024}, S, E);
    } SEAM(6);
    if (IN(7)) { p8_indexer(ws, lds, vcu, G); } SEAM(7);
    if (IN(8)) {
        { pg8::DenseOrder8 S; S.init(ws + WS_H8, ws + WS_WQKV8, NTOK, 2048, 512, 512, G, cid);
          EpiSplitF8 E{ws + WS_Q, ws + WS_K, 1024, 1024, QSCALE / 32.0f, 1.0f / 32.0f};
          pg8::gemm_phase<EpiSplitF8, pg8::DenseOrder8, true, true>(lds, pg8::Gemm{512, 512, 512}, S, E); }
        { pg8::DenseOrder8 S; S.init(ws + WS_WQKV8 + (size_t)2048 * 1024, ws + WS_H8, 1024, NTOK, 512, 512, G, cid);
          EpiSplitF8 E{ws + WS_VT, ws + WS_VT, NTOK, 1 << 30, 1.0f / 32.0f, 1.0f / 32.0f};
          pg8::gemm_phase<EpiSplitF8, pg8::DenseOrder8, true, true>(lds, pg8::Gemm{512, 512, 512}, S, E); }
    } SEAM(8);
    if (IN(9)) { p9_attention(in, ws, lds, vcu, G); } SEAM(9);
    if (IN(11)) {
        { pg8::DenseOrder8 S; S.init(ws + WS_H8, ws + WS_WGL8, NTOK, 1024, 512, 512, G, cid);
          EpiSplitBf16<2, 2> E{(bf16*)(ws + WS_GLR), (bf16*)(ws + WS_GLR), 1024, 1 << 30, 1.0f / 32.0f, 1.0f / 32.0f};
          pg8::gemm_phase<EpiSplitBf16<2, 2>, pg8::DenseOrder8, true, true>(lds, pg8::Gemm{512, 512, 512}, S, E); }
        { pg8::DenseOrder8 S; S.init(ws + WS_H8, ws + WS_WGL8 + (size_t)1024 * 1024, NTOK, 1024, 512, 512, G, cid);
          EpiSplitBf16<2, 2> E{(bf16*)(ws + WS_GLA), (bf16*)(ws + WS_GLA), 1024, 1 << 30, 1.0f / 32.0f, 1.0f / 32.0f};
          pg8::gemm_phase<EpiSplitBf16<2, 2>, pg8::DenseOrder8, true, true>(lds, pg8::Gemm{512, 512, 512}, S, E); }
        asm volatile("s_waitcnt vmcnt(0)" ::: "memory"); __syncthreads();
        { pg8::DenseOrder S; S.init(ws + WS_YRNN, ws + WS_WBRR_T, NTOK, 1024, 1024, 1024, G, cid);
          EpiMerge<0> E{(bf16*)(ws + WS_M1), (const bf16*)(ws + WS_GLR), 1.0f};
          pg8::gemm_phase<EpiMerge<0>, pg8::DenseOrder, true, true>(lds, pg8::Gemm{1024, 1024, 1024}, S, E); }
        asm volatile("s_waitcnt vmcnt(0)" ::: "memory"); __syncthreads();
        { pg8::DenseOrder8 S; S.init(ws + WS_YATT, ws + WS_WBRA8, NTOK, 1024, 512, 512, G, cid);
          EpiMerge<1> E{(bf16*)(ws + WS_M1), (const bf16*)(ws + WS_GLA), 1.0f / 32.0f};
          pg8::gemm_phase<EpiMerge<1>, pg8::DenseOrder8, true, true>(lds, pg8::Gemm{512, 512, 512}, S, E); }
    } SEAM(11);
    if (IN(12)) {
        pg8::DenseOrder S; S.init(ws + WS_M1, ws + WS_WOUT_T, NTOK, 1024, 1024, 1024, G, cid);
        EpiBf16 E{(bf16*)(ws + WS_Y1), 1024};
        pg8::gemm_phase<EpiBf16, pg8::DenseOrder, true, true>(lds, pg8::Gemm{1024, 1024, 1024}, S, E);
    } SEAM(12);
    if (IN(13)) { p13_mid(in, ws, args.out, lds, vcu, G); } SEAM(13);
    if (IN(14)) {
        { pg8::DenseOrder SR; SR.init(ws + WS_H2, ws + WS_WRT_T, NTOK, 256, 1024, 1024, G, cid);
          EpiF32 E{(float*)(ws + WS_LOGITS), 64, 64};
          pg8::gemm_phase<EpiF32, pg8::DenseOrder, true, true>(lds, pg8::Gemm{1024, 1024, 1024}, SR, E); }
        asm volatile("s_waitcnt vmcnt(0)" ::: "memory"); __syncthreads();
        { int tid2 = threadIdx.x; asm volatile("" : "+v"(tid2)); const int lane2 = tid2 & 63, wave2 = __builtin_amdgcn_readfirstlane(tid2 >> 6);
          LAS unsigned* hist = (LAS unsigned*)lds; if (tid2 < 64) hist[tid2] = 0u; __syncthreads();
          unsigned mycount = 0;
          for (int L = cid; L < NTOK / 256; L += G) {
              const int xcd = L % 8, off = L / 8, wg = xcd * ((NTOK / 256) / 8) + off, pm = (wg / 8) * 8 + (wg % 8);
              route_tile(in, ws, pm * 256, wave2, lane2, mycount); }
          if (mycount) lds_add(&hist[lane2], mycount);
          __syncthreads();
          if (tid2 < 64 && hist[tid2]) atomicAdd((unsigned*)(ws + WS_CTL) + CW_CNT + tid2, hist[tid2]);
          __syncthreads(); }
        { pg8::DenseOrder S;
          if (G == 256) { S.init(ws + WS_H2, ws + WS_WSHGU_T, NTOK, 512, 1024, 1024, 128, cid >= 128 ? cid - 128 : 0); if (cid < 128) S.nwg = 0; }
          else S.init(ws + WS_H2, ws + WS_WSHGU_T, NTOK, 512, 1024, 1024, G, cid);
          EpiGlu E{(bf16*)(ws + WS_ACTSH), 1.0f};
          pg8::gemm_phase<EpiGlu, pg8::DenseOrder, true, true>(lds, pg8::Gemm{1024, 1024, 1024}, S, E); }
    } SEAM(14);
    if (IN(15)) {
        p16_fill(ws, lds, vcu, G);
        pg8::DenseOrder S; S.init(ws + WS_ACTSH, ws + WS_WSHD_T, NTOK, 1024, 256, 256, G, cid);
        EpiBf16 E{(bf16*)(ws + WS_Y2), 1024};
        pg8::gemm_phase<EpiBf16, pg8::DenseOrder, true, true>(lds, pg8::Gemm{256, 256, 256}, S, E);
    } SEAM(15);
    if (IN(17)) {
        const int ntiles = (int)((const unsigned*)(ws + WS_CTL))[CW_NT];
        MoeOrder<true, true> S{(const int*)(ws + WS_TILEE), (const int*)(ws + WS_LISTTOK), ntiles * 2, 2, 0, G, cid, (const char*)(ws + WS_H2F8), (const char*)(ws + WS_WEGU8), 0, (size_t)512 * 1024, (size_t)256 * 1024};
        EpiGlu8 E{(unsigned char*)(ws + WS_ACT8), 1.0f / 32.0f};
        pg8::gemm_phase<EpiGlu8, MoeOrder<true, true>, true, true>(lds, pg8::Gemm{512, 512, 512}, S, E);
    } SEAM(17);
    if (IN(18)) {
        const int ntiles = (int)((const unsigned*)(ws + WS_CTL))[CW_NT];
        MoeOrder<false, true> S{(const int*)(ws + WS_TILEE), (const int*)(ws + WS_LISTTOK), ntiles * 4, 4, 0, G, cid, (const char*)(ws + WS_ACT8), (const char*)(ws + WS_WED8), (size_t)256 * 256, (size_t)1024 * 256, (size_t)256 * 256};
        EpiSlot E{ws, (const int*)(ws + WS_LISTP), (const float*)(ws + WS_LISTW), 8.0f / 32.0f};
        pg8::gemm_phase<EpiSlot, MoeOrder<false, true>, true, true>(lds, pg8::Gemm{128, 128, 128}, S, E);
    } SEAM(18);
    if (IN(19)) { p19_final(in, ws, args.out, vcu, G); }
#undef IN
#undef SEAM
}

extern "C" void kernel_launch(void* const* d_in, const int* in_sizes, int n_in, void* d_out, int out_size, void* d_ws, size_t ws_size, hipStream_t stream) {
    static int grid = 0;
    if (grid == 0) {
        if (n_in != 25 || in_sizes[0] != NTOK * DM || out_size != NTOK * DM || ws_size < WS_NEED) { fprintf(stderr, "kernel_launch: unexpected shapes / workspace (%d inputs, ws %zu); nothing launched\n", n_in, ws_size); grid = -1; return; }
        int dev = 0, cus = 0;
        if (hipGetDevice(&dev) != hipSuccess || hipDeviceGetAttribute(&cus, hipDeviceAttributeMultiprocessorCount, dev) != hipSuccess) { grid = -1; return; }
        if (hipFuncSetAttribute((const void*)mk_fwd, hipFuncAttributeMaxDynamicSharedMemorySize, LDS_BYTES) != hipSuccess) { grid = -1; return; }
        int per_cu = 0;
        if (hipOccupancyMaxActiveBlocksPerMultiprocessor(&per_cu, (const void*)mk_fwd, NTHR, LDS_BYTES) != hipSuccess || per_cu < 1) { fprintf(stderr, "kernel_launch: occupancy query says %d\n", per_cu); (void)hipGetLastError(); }
        grid = cus > 256 ? 256 : cus;
    }
    if (grid < 0) return;
    (void)hipMemsetAsync((char*)d_ws + WS_CTL, 0, CTL_ZERO_BYTES, stream);
    Args a{};
    const float** ip = (const float**)&a.in;
    for (int i = 0; i < 25; ++i) ip[i] = (const float*)d_in[i];
    a.out = (float*)d_out; a.ws = (unsigned char*)d_ws;
    a.ph_lo = 0; a.ph_hi = N_PHASES;
    hipLaunchKernelGGL(mk_fwd, dim3(grid), dim3(NTHR), LDS_BYTES, stream, a);
}
```

```cpp
#include <hip/hip_runtime.h>
#include <cstdio>
#include <cstdint>
#include <type_traits>

#define LAS __attribute__((address_space(3)))
#define GAS __attribute__((address_space(1)))
typedef unsigned short bf16;
typedef short bf16x8 __attribute__((ext_vector_type(8)));
typedef float f32x4 __attribute__((ext_vector_type(4)));
typedef float f32x2 __attribute__((ext_vector_type(2)));
typedef float f32x16 __attribute__((ext_vector_type(16)));
typedef unsigned u32x4 __attribute__((ext_vector_type(4)));
typedef short s16x2 __attribute__((ext_vector_type(2)));
typedef unsigned long long u64x8 __attribute__((ext_vector_type(8)));
typedef unsigned u32x2 __attribute__((ext_vector_type(2)));
typedef __bf16 bf16x2_t __attribute__((ext_vector_type(2)));
typedef unsigned long long u64;

__device__ __forceinline__ unsigned cvt_pk_bf16(float lo, float hi) { f32x2 v = {lo, hi}; bf16x2_t b = __builtin_convertvector(v, bf16x2_t); return __builtin_bit_cast(unsigned, b); }
__device__ __forceinline__ float bf_lo(unsigned w) { return __builtin_bit_cast(float, w << 16); }
__device__ __forceinline__ float bf_hi(unsigned w) { return __builtin_bit_cast(float, w & 0xffff0000u); }
__device__ __forceinline__ float fast_exp2(float x) { return __builtin_amdgcn_exp2f(x); }
__device__ __forceinline__ float fast_rcp(float x) { return __builtin_amdgcn_rcpf(x); }
__device__ __forceinline__ float sigmoidf_(float x) { return fast_rcp(1.0f + fast_exp2(-1.4426950408889634f * x)); }
__device__ __forceinline__ float wave_sum(float v) {
#pragma unroll
    for (int o = 1; o < 64; o <<= 1) v += __shfl_xor(v, o);
    return v;
}

namespace pg8 {
constexpr int BM = 256, BK = 64, HALF = 128, HTB = HALF * BK * 2, STAGE_BYTES = 8 * HTB, NXCD = 8, WGM = 8;
__host__ __device__ __forceinline__ int lds_byte(int r, int c) { const int st = (r >> 4) * 2 + (c >> 5), rr = r & 15, cc = c & 31, ob = rr * 64 + cc * 2; return st * 1024 + (ob ^ (((ob >> 9) & 1) << 5)); }
__host__ __device__ __forceinline__ void stage_rc(int b, int& R, int& C) { const int st = b / 1024, sb = b % 1024, swz = sb ^ (((sb >> 9) & 1) << 5); R = (st >> 1) * 16 + swz / 64; C = (st & 1) * 32 + (swz % 64) / 2; }
__host__ __device__ __forceinline__ int perm32(int rho) { const int n = rho >> 4, i = rho & 15; return 8 * (i >> 2) + 4 * n + (i & 3); }

typedef int i32x8 __attribute__((ext_vector_type(8)));
typedef int i32x4 __attribute__((ext_vector_type(4)));
__device__ __forceinline__ i32x8 ld32(const LAS unsigned char* p) { const i32x4 lo = *(const LAS i32x4*)p, hi = *(const LAS i32x4*)(p + 16); return __builtin_shufflevector(lo, hi, 0, 1, 2, 3, 4, 5, 6, 7); }
struct Unit { int pm, pn, e; };
struct Gemm { int lda, ldb, K; };

template <bool F8> struct DenseOrderT {
    static constexpr bool GATHER = false, FP8 = F8;
    int nM, nN, nwg, G, c;
    const char* A; const char* B; size_t a_tile, b_tile; int a_sh; size_t a_mul;
    __device__ void init(const void* A_, const void* B_, int M, int N, int lda, int ldb, int G_, int c_) {
        nM = M / BM; nN = N / BM; nwg = nM * nN; G = G_; c = c_; A = (const char*)A_; B = (const char*)B_;
        a_tile = (size_t)BM * lda * 2; b_tile = (size_t)BM * ldb * 2; a_sh = 0; a_mul = 0; }
    __device__ bool next(int i, Unit& u) const {
        const long L = (long)i * G + c; if (L >= nwg) return false;
        int wgid = (int)L; { const int q = nwg / NXCD, r = nwg % NXCD, xcd = wgid % NXCD, off = wgid / NXCD; wgid = (xcd < r ? xcd * (q + 1) : r * (q + 1) + (xcd - r) * q) + off; }
        const int nig = WGM * nN, gid = wgid / nig, fm = gid * WGM, gsz = (nM - fm) < WGM ? (nM - fm) : WGM;
        u.pm = fm + ((wgid % nig) % gsz); u.pn = (wgid % nig) / gsz; u.e = 0; return true;
    }
    __device__ __forceinline__ const char* pa(const Unit& u) const { return A + (size_t)u.pm * a_tile + (size_t)(u.pn >> a_sh) * a_mul; }
    __device__ __forceinline__ const char* pb(const Unit& u) const { return B + (size_t)u.pn * b_tile; }
    __device__ __forceinline__ unsigned arow(const Unit&, int) const { return 0u; }
};
using DenseOrder = DenseOrderT<false>; using DenseOrder8 = DenseOrderT<true>;

template <class Epi, class Sched, bool ALIGN_EPI, bool SP2>
__device__ __forceinline__ void gemm_phase(LAS unsigned char* lds, const Gemm g, const Sched& S, const Epi& E) {
    const int tid = threadIdx.x, wid = __builtin_amdgcn_readfirstlane(tid >> 6), lane = tid & 63, wr = wid >> 2, wc = wid & 3, fr = lane & 15, fq = lane >> 4;
    int K = g.K; asm volatile("" : "+s"(K));
    const int nt = K / BK;
    constexpr bool GATHER = Sched::GATHER; constexpr bool FP8 = Sched::FP8;
    unsigned cvA0[2], cvA1[2], nvA0[2], nvA1[2], voffB[2]; int Rr[2], Cc[2];
    const unsigned hstepA = (unsigned)HALF * g.lda * 2u; const size_t hstepB = (size_t)HALF * g.ldb * 2;
#pragma unroll
    for (int i = 0; i < 2; ++i) { int R, C; stage_rc(tid * 16 + i * 8192, R, C); const int Rb = Epi::PERM ? ((R & ~31) + perm32(R & 31)) : R;
        Rr[i] = R; Cc[i] = C; cvA0[i] = (unsigned)(R * g.lda + C) * 2u; cvA1[i] = cvA0[i] + hstepA; nvA0[i] = cvA0[i]; nvA1[i] = cvA1[i]; voffB[i] = (unsigned)(Rb * g.ldb + C) * 2u; }
    const size_t kstep = (size_t)(BK * 2);
    const unsigned ldsw = (unsigned)wid * 1024u;
    const int aoff = lds_byte(wr * 64 + fr, FP8 ? fq * 16 : fq * 8), boff = lds_byte(wc * 32 + fr, FP8 ? fq * 16 : fq * 8);
#define PG8_SA(b, h) (((b) * 2 + (h)) * HTB)
#define PG8_SB(b, h) ((4 + (b) * 2 + (h)) * HTB)
#define PG8_STAGE(bufoff, gbase, voff) do { _Pragma("unroll") for (int _i = 0; _i < 2; ++_i) \
        __builtin_amdgcn_global_load_lds((const unsigned*)((const char*)(gbase) + (voff)[_i]), (LAS unsigned*)(lds + (bufoff) + ldsw + _i * 8192), 16, 0, 0); } while (0)
#define PG8_STAGE_A(bufoff, gbase, half, v0, v1) do { if constexpr (GATHER) { if (half) PG8_STAGE(bufoff, gbase, v1); else PG8_STAGE(bufoff, gbase, v0); } else { PG8_STAGE(bufoff, (gbase) + ((half) ? (size_t)hstepA : (size_t)0), cvA0); } } while (0)
#define PG8_LDA(dst, b, h) do { _Pragma("unroll") for (int m = 0; m < 4; ++m) { if constexpr (FP8) dst[m][0] = ld32(lds + PG8_SA(b, h) + aoff + m * 2048); \
        else { _Pragma("unroll") for (int k = 0; k < 2; ++k) dst[m][k] = *(const LAS FragT*)(lds + PG8_SA(b, h) + aoff + m * 2048 + k * 1024); } } } while (0)
#define PG8_LDB(dst, b, h) do { _Pragma("unroll") for (int n = 0; n < 2; ++n) { if constexpr (FP8) dst[n][0] = ld32(lds + PG8_SB(b, h) + boff + n * 2048); \
        else { _Pragma("unroll") for (int k = 0; k < 2; ++k) dst[n][k] = *(const LAS FragT*)(lds + PG8_SB(b, h) + boff + n * 2048 + k * 1024); } } } while (0)
#define PG8_MMA(ai, bj, At, Bt) do { __builtin_amdgcn_s_setprio(1); _Pragma("unroll") for (int m = 0; m < 4; ++m) _Pragma("unroll") for (int n = 0; n < 2; ++n) { \
        if constexpr (FP8) asm volatile("v_mfma_scale_f32_16x16x128_f8f6f4 %0, %1, %2, %0, %3, %3 op_sel_hi:[0,0,0]" : "+v"(acc[ai][bj][m][n]) : "v"(Bt[n][0]), "v"(At[m][0]), "v"(one_scale)); \
        else { _Pragma("unroll") for (int k = 0; k < 2; ++k) acc[ai][bj][m][n] = __builtin_amdgcn_mfma_f32_16x16x32_bf16(Bt[n][k], At[m][k], acc[ai][bj][m][n], 0, 0, 0); } } \
        __builtin_amdgcn_s_setprio(0); } while (0)
#define PG8_WAIT_V(n) asm volatile("s_waitcnt vmcnt(" #n ")" ::: "memory")
#define PG8_WAIT_L(n) asm volatile("s_waitcnt lgkmcnt(" #n ")" ::: "memory")
#define PG8_BAR __builtin_amdgcn_s_barrier()
#define PG8_SCHED __builtin_amdgcn_sched_barrier(0)
    Unit cur, nxt; int ui = 0;
    if (!S.next(0, cur)) return;
    f32x4 acc[2][2][4][2];
#pragma unroll
    for (int a = 0; a < 2; ++a)
#pragma unroll
        for (int b = 0; b < 2; ++b)
#pragma unroll
            for (int m = 0; m < 4; ++m)
#pragma unroll
                for (int n = 0; n < 2; ++n) acc[a][b][m][n] = (f32x4){0.f, 0.f, 0.f, 0.f};
    using FragT = typename std::conditional<FP8, i32x8, bf16x8>::type; constexpr int NK = FP8 ? 1 : 2;
    FragT At[4][NK], B0[2][NK], B1[2][NK]; const int one_scale = 0x7F7F7F7F;
    const char* cA = S.pa(cur); const char* cB = S.pb(cur);
    if constexpr (GATHER) {
#pragma unroll
        for (int i = 0; i < 2; ++i) { cvA0[i] = S.arow(cur, Rr[i]) * (unsigned)(g.lda * 2) + (unsigned)Cc[i] * 2u; cvA1[i] = S.arow(cur, HALF + Rr[i]) * (unsigned)(g.lda * 2) + (unsigned)Cc[i] * 2u; }
    }
    static_assert(SP2, "only the SP2 loop is carried here");
    PG8_STAGE(PG8_SB(0, 0), cB, voffB); PG8_STAGE(PG8_SB(0, 1), cB + hstepB, voffB); PG8_STAGE_A(PG8_SA(0, 0), cA, 0, cvA0, cvA1); PG8_STAGE_A(PG8_SA(0, 1), cA, 1, cvA0, cvA1);
    if (wr == 1) PG8_BAR;
    PG8_WAIT_V(2); PG8_BAR;
    PG8_STAGE(PG8_SB(1, 0), cB + kstep, voffB); PG8_STAGE_A(PG8_SA(1, 0), cA + kstep, 0, cvA0, cvA1); PG8_STAGE(PG8_SB(1, 1), cB + hstepB + kstep, voffB);
    PG8_WAIT_V(6); PG8_BAR;
    for (;;) {
        const bool has_next = S.next(ui + 1, nxt);
        const char* nA = has_next ? S.pa(nxt) : cA; const char* nB = has_next ? S.pb(nxt) : cB;
        for (int t = 0; t < nt; t += 2) {
            const bool last = (t == nt - 2);
            const char* a1 = cA + (size_t)(t + 1) * kstep;
            const char* a2 = last ? nA : cA + (size_t)(t + 2) * kstep; const char* b2 = last ? nB : cB + (size_t)(t + 2) * kstep;
            const char* a3 = a2 + kstep; const char* b3 = b2 + kstep;
            unsigned xv0[2], xv1[2];
            if constexpr (GATHER) {
                if (last && has_next) {
#pragma unroll
                    for (int i = 0; i < 2; ++i) { nvA0[i] = S.arow(nxt, Rr[i]) * (unsigned)(g.lda * 2) + (unsigned)Cc[i] * 2u; nvA1[i] = S.arow(nxt, HALF + Rr[i]) * (unsigned)(g.lda * 2) + (unsigned)Cc[i] * 2u; }
                }
#pragma unroll
                for (int i = 0; i < 2; ++i) { xv0[i] = (last && has_next) ? nvA0[i] : cvA0[i]; xv1[i] = (last && has_next) ? nvA1[i] : cvA1[i]; }
            } else { xv0[0] = xv0[1] = xv1[0] = xv1[1] = 0u; }
            PG8_LDB(B0, 0, 0); PG8_LDB(B1, 0, 1); PG8_SCHED; PG8_LDA(At, 0, 0); PG8_STAGE_A(PG8_SA(1, 1), a1, 1, cvA0, cvA1);
            PG8_WAIT_V(8); PG8_WAIT_L(0); PG8_BAR; PG8_MMA(0, 0, At, B0); PG8_MMA(0, 1, At, B1); PG8_BAR; PG8_SCHED;
            PG8_LDA(At, 0, 1); PG8_STAGE(PG8_SB(0, 0), b2, voffB); PG8_STAGE(PG8_SB(0, 1), b2 + hstepB, voffB); PG8_STAGE_A(PG8_SA(0, 0), a2, 0, xv0, xv1);
            PG8_WAIT_V(8); PG8_WAIT_L(0); PG8_BAR; PG8_MMA(1, 0, At, B0); PG8_MMA(1, 1, At, B1); PG8_BAR; PG8_SCHED;
            PG8_LDB(B0, 1, 0); PG8_LDB(B1, 1, 1); PG8_SCHED; PG8_LDA(At, 1, 0); PG8_STAGE_A(PG8_SA(0, 1), a2, 1, xv0, xv1);
            PG8_WAIT_V(8); PG8_WAIT_L(0); PG8_BAR; PG8_MMA(0, 0, At, B0); PG8_MMA(0, 1, At, B1); PG8_BAR; PG8_SCHED;
            PG8_LDA(At, 1, 1); PG8_STAGE(PG8_SB(1, 0), b3, voffB); PG8_STAGE(PG8_SB(1, 1), b3 + hstepB, voffB); PG8_STAGE_A(PG8_SA(1, 0), a3, 0, xv0, xv1);
            PG8_WAIT_V(8); PG8_WAIT_L(0); PG8_BAR; PG8_MMA(1, 0, At, B0); PG8_MMA(1, 1, At, B1); PG8_BAR; PG8_SCHED;
        }
        if constexpr (ALIGN_EPI) { if (wr == 0) PG8_BAR; }
        E(acc, cur, wr, wc, fr, fq);
        if (!has_next) break;
#pragma unroll
        for (int a = 0; a < 2; ++a)
#pragma unroll
            for (int b = 0; b < 2; ++b)
#pragma unroll
                for (int m = 0; m < 4; ++m)
#pragma unroll
                    for (int n = 0; n < 2; ++n) acc[a][b][m][n] = (f32x4){0.f, 0.f, 0.f, 0.f};
        cur = nxt; cA = nA; cB = nB; ++ui;
        if constexpr (GATHER) {
#pragma unroll
            for (int i = 0; i < 2; ++i) { cvA0[i] = nvA0[i]; cvA1[i] = nvA1[i]; }
        }
        if constexpr (ALIGN_EPI) { if (wr == 1) PG8_BAR; }
    }
    PG8_WAIT_V(0);
    if constexpr (!ALIGN_EPI) { if (wr == 0) PG8_BAR; }
    PG8_BAR;
#undef PG8_SA
#undef PG8_SB
#undef PG8_STAGE
#undef PG8_STAGE_A
#undef PG8_LDA
#undef PG8_LDB
#undef PG8_MMA
#undef PG8_WAIT_V
#undef PG8_WAIT_L
#undef PG8_BAR
#undef PG8_SCHED
}
}

#define XB_TMO      128
#define XB_XCNT(j)  (256  + 64 * (j))
#define XB_XSUB(j)  (1280 + 64 * (j))
#define XB_XGEN(j)  (2304 + 64 * (j))
#define XB_TOP      3328
#define XB_TOPGEN   3392
#define XCD_BAR_WORDS 3456
#define XB_SPIN_CAP (1u << 18)

__device__ __forceinline__ unsigned xb_ld(unsigned* p)              { return __hip_atomic_load(p, __ATOMIC_RELAXED, __HIP_MEMORY_SCOPE_AGENT); }
__device__ __forceinline__ unsigned xb_add(unsigned* p, unsigned v) { return __hip_atomic_fetch_add(p, v, __ATOMIC_RELAXED, __HIP_MEMORY_SCOPE_AGENT); }
__device__ __forceinline__ unsigned xb_xcc_id() { return (unsigned)__builtin_amdgcn_s_getreg((3 << 11) | 20) & 0xFu; }
#define XB_SPIN(cond, bar) do { unsigned _sp = 0; while (cond) { __builtin_amdgcn_s_sleep(1); \
    if ((++_sp & 255u) == 0u) { if (xb_ld(&(bar)[XB_TMO])) break; if (_sp > XB_SPIN_CAP) { atomicAdd(&(bar)[XB_TMO], 1u); break; } } } } while (0)

struct XcdBarrier { unsigned* bar; unsigned x; volatile LAS unsigned* st; };

__device__ __forceinline__ XcdBarrier xcd_barrier_post(unsigned* bar, volatile LAS unsigned* st) {
    XcdBarrier b; b.bar = bar; b.x = xb_xcc_id(); b.st = st;
    if (threadIdx.x == 0) (void)xb_add(&bar[XB_XCNT(b.x)], 1u);
    return b;
}
__device__ __forceinline__ void xcd_barrier_complete(unsigned* bar, unsigned x, unsigned& nloc, unsigned& nx) {
    const unsigned G = gridDim.x * gridDim.y * gridDim.z;
    unsigned sum, cnt, mine, sp = 0u;
    for (;;) {
        sum = 0u; cnt = 0u; mine = 0u;
#pragma unroll
        for (unsigned j = 0; j < 16; ++j) { const unsigned c = xb_ld(&bar[XB_XCNT(j)]); sum += c; cnt += (c > 0u) ? 1u : 0u; mine = (j == x) ? c : mine; }
        if (sum == G) break;
        __builtin_amdgcn_s_sleep(1);
        if ((++sp & 255u) == 0u) { if (xb_ld(&bar[XB_TMO])) break; if (sp > XB_SPIN_CAP) { atomicAdd(&bar[XB_TMO], 1u); break; } }
    }
    nloc = mine > 0u ? mine : 1u; nx = cnt > 0u ? cnt : 1u;
}
__device__ __forceinline__ void xcd_barrier(const XcdBarrier& b) {
    asm volatile("s_waitcnt vmcnt(0)" ::: "memory");
    __syncthreads();
    if (threadIdx.x == 0) {
        unsigned* bar = b.bar;
        __builtin_amdgcn_s_waitcnt(0);
        unsigned nloc = b.st[0], nx = b.st[1];
        if (nloc == 0u) { xcd_barrier_complete(bar, b.x, nloc, nx); b.st[0] = nloc; b.st[1] = nx; }
        const unsigned old = xb_add(&bar[XB_XSUB(b.x)], 1u);
        const unsigned gen = old / nloc;
        if (old + 1u == (gen + 1u) * nloc) {
            __builtin_amdgcn_fence(__ATOMIC_RELEASE, "agent");
            asm volatile("s_waitcnt vmcnt(0)" ::: "memory");
            const unsigned og = xb_add(&bar[XB_TOP], 1u);
            const unsigned tg = og / nx;
            if (og + 1u == (tg + 1u) * nx) xb_add(&bar[XB_TOPGEN], 1u);
            else XB_SPIN(xb_ld(&bar[XB_TOPGEN]) == tg, bar);
            __builtin_amdgcn_fence(__ATOMIC_ACQUIRE, "agent");
            xb_add(&bar[XB_XGEN(b.x)], 1u);
            asm volatile("s_waitcnt vmcnt(0)" ::: "memory");
        } else {
            XB_SPIN(xb_ld(&bar[XB_XGEN(b.x)]) == gen, bar);
            __builtin_amdgcn_fence(__ATOMIC_ACQUIRE, "agent");
            asm volatile("s_waitcnt vmcnt(0)" ::: "memory");
        }
    }
    __syncthreads();
}

constexpr int NB = 4, SEQ = 8192, DM = 1024, NTOK = NB * SEQ, WIN = 8272, NEXP = 64, DEXP = 256, TOPK = 8;
constexpr int C_UGATE = 1024, C_Q = 2048, C_V = 4096, C_QI = 5120, C_GLR = 6224;
constexpr int NWAVES = 8, NTHR = 512;
constexpr float EPSN = 1e-6f, LOG2E = 1.4426950408889634f;
constexpr float QSCALE = 0.08838834764831845f * 1.4426950408889634f;
constexpr size_t MiB = 1u << 20;
constexpr size_t WS_CTL = 0, CTL_ZERO_BYTES = 1 * MiB;
constexpr int CW_BAR = 4096, CW_MOD = 16384, CW_CNT = 65536, CW_CUR = 65536 + 64, CW_NT = 65536 + 128;
constexpr size_t WS_TOKSEL = 1 * MiB, WS_TOKW = 2 * MiB, WS_LISTTOK = 3 * MiB, WS_LISTW = 4 * MiB + MiB / 2, WS_TILEE = 6 * MiB, WS_CHA = 8 * MiB, WS_CHH = 10 * MiB, WS_SPL = 12 * MiB, WS_LISTP = 13 * MiB;
constexpr size_t WS_WIN_T = 17 * MiB, WS_WG_T = 34 * MiB, WS_WBRR_T = 35 * MiB, WS_WBRA_T = 37 * MiB, WS_WOUT_T = 39 * MiB, WS_WRT_T = 41 * MiB, WS_WSHGU_T = 42 * MiB, WS_WSHD_T = 43 * MiB, WS_WQKV8 = 44 * MiB, WS_WGL8 = WS_WIN_T + (size_t)C_Q * 2048, WS_WBRA8 = WS_WGL8 + 2 * MiB;
constexpr size_t S0 = 48 * MiB, S1 = 112 * MiB, S2 = 176 * MiB, S3 = 240 * MiB, S4 = 304 * MiB, S5 = 368 * MiB, S6 = 432 * MiB, SX = 496 * MiB, WS_NEED = 504 * MiB;
constexpr size_t WS_H = S0, WS_URNN = S1, WS_GGATE = S2, WS_XC = S3, WS_LOGA = S4, WS_BB = S5, WS_YRNN = S1;
constexpr size_t WS_QI = S3, WS_KI = SX, WS_WI = SX + 4 * MiB, WS_SCR = S4, WS_MASK = S6;
constexpr size_t WS_Q = S2, WS_K = S3, WS_VT = S4, WS_YATT = S5, WS_H8 = S6 + 32 * MiB;
constexpr size_t WS_GLR = S2, WS_GLA = S3, WS_M1 = S4, WS_Y1 = S0;
constexpr size_t WS_H2 = S2, WS_WEGU = S3, WS_WED = S4, WS_ACTSH = S4 + 32 * MiB, WS_LOGITS = S4 + 48 * MiB, WS_ACT = S5, WS_Y2 = S0, WS_SLOT = S2, WS_WEGU8 = S3, WS_H2F8 = S3 + 32 * MiB, WS_WED8 = S4, WS_ACT8 = S5, WS_SLOTB2 = S5 + 68 * MiB;
__device__ __forceinline__ unsigned char* slot_row(unsigned char* ws, int pair) { return (pair < 131072 ? ws + S2 + (size_t)pair * 1024 : (pair < 196608 ? ws + S1 + (size_t)(pair - 131072) * 1024 : ws + WS_SLOTB2 + (size_t)(pair - 196608) * 1024)); }
constexpr int LDS_BYTES = 147456, LDSCTL_OFF = 145408;

using pg8::Unit;
#define EPI_ROWS for (int ai = 0; ai < 2; ++ai) _Pragma("unroll") for (int m = 0; m < 4; ++m)
__device__ __forceinline__ u32x4 pack8(const f32x4 a, const f32x4 b) { u32x4 w; w.x = cvt_pk_bf16(a[0], a[1]); w.y = cvt_pk_bf16(a[2], a[3]); w.z = cvt_pk_bf16(b[0], b[1]); w.w = cvt_pk_bf16(b[2], b[3]); return w; }
__device__ __forceinline__ void unpack8(const u32x4 w, f32x4& a, f32x4& b) { a[0] = bf_lo(w.x); a[1] = bf_hi(w.x); a[2] = bf_lo(w.y); a[3] = bf_hi(w.y); b[0] = bf_lo(w.z); b[1] = bf_hi(w.z); b[2] = bf_lo(w.w); b[3] = bf_hi(w.w); }
__device__ __forceinline__ float clamp_e4m3(float x) { return __builtin_fminf(__builtin_fmaxf(x, -448.0f), 448.0f); }
__device__ __forceinline__ float gelu_tanh(float x) { const float u = 0.7978845608028654f * (x + 0.044715f * x * x * x); return x * fast_rcp(1.0f + fast_exp2(-2.0f * LOG2E * u)); }

template <int MODE0, int MODE1> struct EpiSplitBf16 {
    static constexpr bool PERM = true;
    bf16* O0; bf16* O1; int ldc; int split; float s0, s1;
    __device__ __forceinline__ void operator()(const f32x4 (&acc)[2][2][4][2], const Unit& u, int wr, int wc, int fr, int fq) const {
        int colt = u.pn * 256; const bool second = colt >= split; bf16* base = second ? O1 : O0; if (second) colt -= split; const float sc = second ? s1 : s0;
        const int row0 = u.pm * 256 + wr * 64 + fr, col0 = colt + wc * 32 + 8 * fq;
#pragma unroll
        EPI_ROWS { bf16* rowp = base + (size_t)(row0 + ai * 128 + m * 16) * ldc + col0;
#pragma unroll
            for (int bj = 0; bj < 2; ++bj) { f32x4 v0 = acc[ai][bj][m][0], v1 = acc[ai][bj][m][1];
                const int mode = second ? MODE1 : MODE0;
                if (mode == 0) { v0 = v0 * sc; v1 = v1 * sc; }
                else if (mode == 1) {
#pragma unroll
                    for (int j = 0; j < 4; ++j) { v0[j] = gelu_tanh(v0[j]); v1[j] = gelu_tanh(v1[j]); } }
                else {
#pragma unroll
                    for (int j = 0; j < 4; ++j) { v0[j] = sigmoidf_(v0[j] * sc); v1[j] = sigmoidf_(v1[j] * sc); } }
                *(u32x4*)(rowp + bj * 128) = pack8(v0, v1); } }
    }
};
struct EpiSplitF8 {
    static constexpr bool PERM = true;
    unsigned char* O0; unsigned char* O1; int ldc; int split; float s0, s1;
    __device__ __forceinline__ void operator()(const f32x4 (&acc)[2][2][4][2], const Unit& u, int wr, int wc, int fr, int fq) const {
        int colt = u.pn * 256; const bool second = colt >= split; unsigned char* base = second ? O1 : O0; if (second) colt -= split; const float sc = second ? s1 : s0;
        const int row0 = u.pm * 256 + wr * 64 + fr, col0 = colt + wc * 32 + 8 * fq;
#pragma unroll
        EPI_ROWS { unsigned char* rowp = base + (size_t)(row0 + ai * 128 + m * 16) * ldc + col0;
#pragma unroll
            for (int bj = 0; bj < 2; ++bj) { f32x4 a = acc[ai][bj][m][0] * sc, b = acc[ai][bj][m][1] * sc;
#pragma unroll
                for (int j = 0; j < 4; ++j) { a[j] = clamp_e4m3(a[j]); b[j] = clamp_e4m3(b[j]); }
                int w0 = __builtin_amdgcn_cvt_pk_fp8_f32(a[0], a[1], 0, false); w0 = __builtin_amdgcn_cvt_pk_fp8_f32(a[2], a[3], w0, true);
                int w1 = __builtin_amdgcn_cvt_pk_fp8_f32(b[0], b[1], 0, false); w1 = __builtin_amdgcn_cvt_pk_fp8_f32(b[2], b[3], w1, true);
                *(u32x2*)(rowp + bj * 128) = (u32x2){(unsigned)w0, (unsigned)w1}; } }
    }
};
struct EpiIdx {
    static constexpr bool PERM = true;
    bf16* QI; bf16* KI; float* WI;
    __device__ __forceinline__ void operator()(const f32x4 (&acc)[2][2][4][2], const Unit& u, int wr, int wc, int fr, int fq) const {
        const int row0 = u.pm * 256 + wr * 64 + fr;
        if (u.pn < 4) { const int col0 = u.pn * 256 + wc * 32 + 8 * fq;
#pragma unroll
            EPI_ROWS { bf16* rowp = QI + (size_t)(row0 + ai * 128 + m * 16) * 1024 + col0;
#pragma unroll
                for (int bj = 0; bj < 2; ++bj) *(u32x4*)(rowp + bj * 128) = pack8(acc[ai][bj][m][0] * 0.125f, acc[ai][bj][m][1] * 0.125f); }
        } else { const int col0 = wc * 32 + 8 * fq;
#pragma unroll
            EPI_ROWS { const size_t row = (size_t)(row0 + ai * 128 + m * 16);
                if (col0 < 64) *(u32x4*)(KI + row * 64 + col0) = pack8(acc[ai][0][m][0], acc[ai][0][m][1]);
                else if (col0 < 80) { *(f32x4*)(WI + row * 16 + (col0 - 64)) = acc[ai][0][m][0] * 0.125f; *(f32x4*)(WI + row * 16 + (col0 - 64) + 4) = acc[ai][0][m][1] * 0.125f; } }
        }
    }
};
struct EpiBf16 {
    static constexpr bool PERM = true;
    bf16* O; int ldc;
    __device__ __forceinline__ void operator()(const f32x4 (&acc)[2][2][4][2], const Unit& u, int wr, int wc, int fr, int fq) const {
        const int row0 = u.pm * 256 + wr * 64 + fr, col0 = u.pn * 256 + wc * 32 + 8 * fq;
#pragma unroll
        EPI_ROWS { bf16* rowp = O + (size_t)(row0 + ai * 128 + m * 16) * ldc + col0;
#pragma unroll
            for (int bj = 0; bj < 2; ++bj) *(u32x4*)(rowp + bj * 128) = pack8(acc[ai][bj][m][0], acc[ai][bj][m][1]); }
    }
};
template <int MODE> struct EpiMerge {
    static constexpr bool PERM = true;
    bf16* O; const bf16* Gt; float isc;
    __device__ __forceinline__ void operator()(const f32x4 (&acc)[2][2][4][2], const Unit& u, int wr, int wc, int fr, int fq) const {
        const int row0 = u.pm * 256 + wr * 64 + fr, col0 = u.pn * 256 + wc * 32 + 8 * fq;
#pragma unroll
        EPI_ROWS { const size_t off = (size_t)(row0 + ai * 128 + m * 16) * 1024 + col0;
#pragma unroll
            for (int bj = 0; bj < 2; ++bj) { f32x4 g0, g1; unpack8(*(const u32x4*)(Gt + off + bj * 128), g0, g1);
                f32x4 v0 = g0 * (acc[ai][bj][m][0] * isc), v1 = g1 * (acc[ai][bj][m][1] * isc);
                if (MODE == 1) { f32x4 o0, o1; unpack8(*(const u32x4*)(O + off + bj * 128), o0, o1); v0 = v0 + o0; v1 = v1 + o1; }
                *(u32x4*)(O + off + bj * 128) = pack8(v0, v1); } }
    }
};
struct EpiF32 {
    static constexpr bool PERM = false;
    float* C; int ldc; int ncols;
    __device__ __forceinline__ void operator()(const f32x4 (&acc)[2][2][4][2], const Unit& u, int wr, int wc, int fr, int fq) const {
        const int row0 = u.pm * 256 + wr * 64 + fr, col0 = u.pn * 256 + wc * 32 + 4 * fq;
#pragma unroll
        EPI_ROWS { float* rowp = C + (size_t)(row0 + ai * 128 + m * 16) * ldc + col0;
#pragma unroll
            for (int bj = 0; bj < 2; ++bj)
#pragma unroll
                for (int n = 0; n < 2; ++n) if (col0 + bj * 128 + n * 16 < ncols) *(f32x4*)(rowp + bj * 128 + n * 16) = acc[ai][bj][m][n]; }
    }
};
struct EpiGate {
    static constexpr bool PERM = true;
    const bf16* XC; bf16* LOGA; bf16* BB; const float* b_a; const float* b_x; const float* lam;
    __device__ __forceinline__ void operator()(const f32x4 (&acc)[2][2][4][2], const Unit& u, int wr, int wc, int fr, int fq) const {
        const int row0 = u.pm * 256 + wr * 64 + fr;
#pragma unroll
        for (int n = 0; n < 2; ++n) { const int ch0 = u.pn * 128 + wc * 32 + 8 * fq + 4 * n;
            const f32x4 ba = *(const f32x4*)(b_a + ch0), bx = *(const f32x4*)(b_x + ch0), sp = *(const f32x4*)(lam + ch0);
#pragma unroll
            EPI_ROWS { const size_t off = (size_t)(row0 + ai * 128 + m * 16) * 1024 + ch0;
                const u32x2 xw = *(const u32x2*)(XC + off); const f32x4 xv = {bf_lo(xw.x), bf_hi(xw.x), bf_lo(xw.y), bf_hi(xw.y)};
                f32x4 la, bv;
#pragma unroll
                for (int j = 0; j < 4; ++j) {
                    const float r = sigmoidf_(acc[ai][0][m][n][j] + ba[j]), ig = sigmoidf_(acc[ai][1][m][n][j] + bx[j]);
                    la[j] = r * sp[j]; bv[j] = ig * xv[j]; }
                u32x2 w0, w1; w0.x = cvt_pk_bf16(la[0], la[1]); w0.y = cvt_pk_bf16(la[2], la[3]); w1.x = cvt_pk_bf16(bv[0], bv[1]); w1.y = cvt_pk_bf16(bv[2], bv[3]);
                *(u32x2*)(LOGA + off) = w0; *(u32x2*)(BB + off) = w1; asm volatile("" ::: "memory"); } }
    }
};
struct EpiGlu {
    static constexpr bool PERM = true;
    bf16* ACT; float isc;
    __device__ __forceinline__ void operator()(const f32x4 (&acc)[2][2][4][2], const Unit& u, int wr, int wc, int fr, int fq) const {
        const int row0 = u.pm * 256 + wr * 64 + fr, col0 = u.pn * 128 + wc * 32 + 8 * fq;
#pragma unroll
        EPI_ROWS { f32x4 v0, v1;
#pragma unroll
            for (int j = 0; j < 4; ++j) { const float g0 = acc[ai][0][m][0][j] * isc, g1 = acc[ai][0][m][1][j] * isc; v0[j] = g0 * sigmoidf_(g0) * (acc[ai][1][m][0][j] * isc); v1[j] = g1 * sigmoidf_(g1) * (acc[ai][1][m][1][j] * isc); }
            *(u32x4*)(ACT + (size_t)(row0 + ai * 128 + m * 16) * 256 + col0) = pack8(v0, v1); }
    }
};
struct EpiGlu8 {
    static constexpr bool PERM = true;
    unsigned char* ACT; float isc;
    __device__ __forceinline__ void operator()(const f32x4 (&acc)[2][2][4][2], const Unit& u, int wr, int wc, int fr, int fq) const {
        const int row0 = u.pm * 256 + wr * 64 + fr, col0 = u.pn * 128 + wc * 32 + 8 * fq;
#pragma unroll
        EPI_ROWS { float v[8];
#pragma unroll
            for (int j = 0; j < 4; ++j) { const float g0 = acc[ai][0][m][0][j] * isc, g1 = acc[ai][0][m][1][j] * isc; v[j] = clamp_e4m3(g0 * sigmoidf_(g0) * (acc[ai][1][m][0][j] * isc)); v[4 + j] = clamp_e4m3(g1 * sigmoidf_(g1) * (acc[ai][1][m][1][j] * isc)); }
            int w0 = __builtin_amdgcn_cvt_pk_fp8_f32(v[0], v[1], 0, false); w0 = __builtin_amdgcn_cvt_pk_fp8_f32(v[2], v[3], w0, true);
            int w1 = __builtin_amdgcn_cvt_pk_fp8_f32(v[4], v[5], 0, false); w1 = __builtin_amdgcn_cvt_pk_fp8_f32(v[6], v[7], w1, true);
            *(u32x2*)(ACT + (size_t)(row0 + ai * 128 + m * 16) * 256 + col0) = (u32x2){(unsigned)w0, (unsigned)w1}; }
    }
};
struct EpiSlot {
    static constexpr bool PERM = true;
    unsigned char* ws; const int* list_pair; const float* list_w; float isc;
    __device__ __forceinline__ void operator()(const f32x4 (&acc)[2][2][4][2], const Unit& u, int wr, int wc, int fr, int fq) const {
        const int row0 = u.pm * 256 + wr * 64 + fr, col0 = u.pn * 256 + wc * 32 + 8 * fq;
#pragma unroll
        EPI_ROWS { const int pos = row0 + ai * 128 + m * 16; const float w = list_w[pos] * isc; const int pair = list_pair[pos];
            if (pair >= 0) { unsigned char* rowp = slot_row(ws, pair) + col0;
#pragma unroll
                for (int bj = 0; bj < 2; ++bj) { f32x4 a = acc[ai][bj][m][0] * w, b = acc[ai][bj][m][1] * w;
#pragma unroll
                    for (int j = 0; j < 4; ++j) { a[j] = clamp_e4m3(a[j]); b[j] = clamp_e4m3(b[j]); }
                    int w0 = __builtin_amdgcn_cvt_pk_fp8_f32(a[0], a[1], 0, false); w0 = __builtin_amdgcn_cvt_pk_fp8_f32(a[2], a[3], w0, true);
                    int w1 = __builtin_amdgcn_cvt_pk_fp8_f32(b[0], b[1], 0, false); w1 = __builtin_amdgcn_cvt_pk_fp8_f32(b[2], b[3], w1, true);
                    *(u32x2*)(rowp + bj * 128) = (u32x2){(unsigned)w0, (unsigned)w1}; } } }
    }
};
template <bool GATH, bool F8 = false> struct MoeOrder {
    static constexpr bool GATHER = GATH, FP8 = F8;
    const int* tile_e; const int* list_tok; int nunits, ntn, pn0, G, c; const char* A; const char* B; size_t a_tile, b_e, b_tile;
    __device__ bool next(int i, Unit& u) const {
        int L;
        if ((G & 7) == 0) { const int q = nunits / 8, r = nunits % 8, xcd = c & 7, off = i * (G >> 3) + (c >> 3), len = q + (xcd < r ? 1 : 0); if (off >= len) return false; L = (xcd < r ? xcd * (q + 1) : r * (q + 1) + (xcd - r) * q) + off; }
        else { const long Ll = (long)i * G + c; if (Ll >= nunits) return false; L = (int)Ll; }
        u.pm = L / ntn; u.pn = pn0 + L % ntn; u.e = tile_e[u.pm]; return true; }
    __device__ __forceinline__ const char* pa(const Unit& u) const { return GATH ? A : A + (size_t)u.pm * a_tile; }
    __device__ __forceinline__ const char* pb(const Unit& u) const { return B + (size_t)u.e * b_e + (size_t)u.pn * b_tile; }
    __device__ __forceinline__ unsigned arow(const Unit& u, int r) const { return (unsigned)list_tok[u.pm * 256 + r]; }
};

#define LDS_WAIT() asm volatile("s_waitcnt lgkmcnt(0)" ::: "memory")
__device__ __forceinline__ unsigned lds_add(LAS unsigned* p, unsigned v) { return __hip_atomic_fetch_add(p, v, __ATOMIC_RELAXED, __HIP_MEMORY_SCOPE_WORKGROUP); }

__device__ __forceinline__ void tr_item(const float* W, int ldw, int N, bf16* WT, int ldt, int blk, int blkstride, int rowoff, LAS float* scr, int kb, int nb, int lane) {
    const int k0 = 64 * kb, n0 = 32 * nb;
    float tv[32];
#pragma unroll
    for (int i = 0; i < 32; ++i) { const int kk = 2 * i + (lane >> 5), n = n0 + (lane & 31); tv[i] = (n < N) ? W[(size_t)(k0 + kk) * ldw + n] : 0.f; }
#pragma unroll
    for (int i = 0; i < 32; ++i) { const int kk = 2 * i + (lane >> 5); scr[kk * 33 + (lane & 31)] = tv[i]; }
    LDS_WAIT(); asm volatile("" ::: "memory");
    const int c = lane & 7;
#pragma unroll
    for (int j = 0; j < 4; ++j) { const int nl = (lane >> 3) + 8 * j, n = n0 + nl; const LAS float* s = scr + (8 * c) * 33 + nl;
        u32x4 o; o.x = cvt_pk_bf16(s[0 * 33], s[1 * 33]); o.y = cvt_pk_bf16(s[2 * 33], s[3 * 33]); o.z = cvt_pk_bf16(s[4 * 33], s[5 * 33]); o.w = cvt_pk_bf16(s[6 * 33], s[7 * 33]);
        if (n < N) { const int drow = rowoff + (n / blk) * blkstride + (n % blk); *(u32x4*)(WT + (size_t)drow * ldt + k0 + 8 * c) = o; } }
    LDS_WAIT(); asm volatile("" ::: "memory");
}
__device__ __forceinline__ unsigned cvt4_fp8(float a, float b, float c, float d) { int w = __builtin_amdgcn_cvt_pk_fp8_f32(a, b, 0, false); w = __builtin_amdgcn_cvt_pk_fp8_f32(c, d, w, true); return (unsigned)w; }
__device__ __forceinline__ void tr_item_fp8(const float* W, int ldw, int N, unsigned char* WT, int ldt, int blk, int blkstride, int rowoff, float scale, LAS float* scr, int kb, int nb, int lane) {
    const int k0 = 64 * kb, n0 = 32 * nb;
    float tv[32];
#pragma unroll
    for (int i = 0; i < 32; ++i) { const int kk = 2 * i + (lane >> 5), n = n0 + (lane & 31); tv[i] = (n < N) ? W[(size_t)(k0 + kk) * ldw + n] : 0.f; }
#pragma unroll
    for (int i = 0; i < 32; ++i) { const int kk = 2 * i + (lane >> 5); scr[kk * 33 + (lane & 31)] = tv[i]; }
    LDS_WAIT(); asm volatile("" ::: "memory");
    const int c = lane & 7;
#pragma unroll
    for (int j = 0; j < 4; ++j) { const int nl = (lane >> 3) + 8 * j, n = n0 + nl; const LAS float* s = scr + (8 * c) * 33 + nl;
        u32x2 o; o.x = cvt4_fp8(s[0 * 33] * scale, s[1 * 33] * scale, s[2 * 33] * scale, s[3 * 33] * scale); o.y = cvt4_fp8(s[4 * 33] * scale, s[5 * 33] * scale, s[6 * 33] * scale, s[7 * 33] * scale);
        if (n < N) { const int drow = rowoff + (n / blk) * blkstride + (n % blk); *(u32x2*)(WT + (size_t)drow * ldt + k0 + 8 * c) = o; } }
    LDS_WAIT(); asm volatile("" ::: "memory");
}
__device__ __forceinline__ void tr_matrix(const float* W, int K, int N, int ldw, bf16* WT, int ldt, int blk, int blkstride, int rowoff, LAS float* scr, int gw, int NGW, int lane) {
    const int nbn = (N + 31) / 32, nit = (K / 64) * nbn;
    for (int it = gw; it < nit; it += NGW) tr_item(W, ldw, N, WT, ldt, blk, blkstride, rowoff, scr, it / nbn, it % nbn, lane);
}

struct In {
    const float *x, *c, *w_ada, *b_ada, *norm_gain, *w_in, *conv_w, *conv_b, *w_rg_a, *b_rg_a, *w_rg_x, *b_rg_x, *lru_lambda, *w_br_rnn, *w_br_attn, *w_out, *rel_bias,
                *w_router, *router_bias, *w_exp_gate, *w_exp_up, *w_exp_down, *w_sh_gate, *w_sh_up, *w_sh_down;
};

__device__ __forceinline__ void p0_prologue(const In& in, unsigned char* ws, LAS unsigned char* lds, int vcu, int G) {
    const int tid = threadIdx.x, lane = tid & 63, wave = __builtin_amdgcn_readfirstlane(tid >> 6);
    LAS float* scr = (LAS float*)(lds + wave * 16384);
    const int gw = vcu * NWAVES + wave, NGW = G * NWAVES;
    tr_matrix(in.w_in, 1024, C_Q, WIN, (bf16*)(ws + WS_WIN_T), 1024, 1 << 30, 0, 0, scr, gw, NGW, lane);
    tr_matrix(in.w_in + C_QI, 1024, C_GLR - C_QI, WIN, (bf16*)(ws + WS_WIN_T) + (size_t)C_QI * 1024, 1024, 1 << 30, 0, 0, scr, gw, NGW, lane);
    for (int it = gw; it < 16 * 64; it += NGW) tr_item_fp8(in.w_in + C_GLR, WIN, 2048, ws + WS_WGL8, 1024, 1 << 30, 0, 0, 32.0f, scr, it / 64, it % 64, lane);
    for (int it = gw; it < 16 * 96; it += NGW) tr_item_fp8(in.w_in + C_Q, WIN, 3072, ws + WS_WQKV8, 1024, 1 << 30, 0, 0, 32.0f, scr, it / 96, it % 96, lane);
    tr_matrix(in.w_br_rnn, 1024, 1024, 1024, (bf16*)(ws + WS_WBRR_T), 1024, 1 << 30, 0, 0, scr, gw, NGW, lane);
    for (int it = gw; it < 16 * 32; it += NGW) tr_item_fp8(in.w_br_attn, 1024, 1024, ws + WS_WBRA8, 1024, 1 << 30, 0, 0, 32.0f, scr, it / 32, it % 32, lane);
    tr_matrix(in.w_out, 1024, 1024, 1024, (bf16*)(ws + WS_WOUT_T), 1024, 1 << 30, 0, 0, scr, gw, NGW, lane);
    tr_matrix(in.w_router, 1024, 64, 64, (bf16*)(ws + WS_WRT_T), 1024, 1 << 30, 0, 0, scr, gw, NGW, lane);
    tr_matrix(in.w_sh_gate, 1024, 256, 256, (bf16*)(ws + WS_WSHGU_T), 1024, 128, 256, 0, scr, gw, NGW, lane);
    tr_matrix(in.w_sh_up, 1024, 256, 256, (bf16*)(ws + WS_WSHGU_T), 1024, 128, 256, 128, scr, gw, NGW, lane);
    tr_matrix(in.w_sh_down, 256, 1024, 1024, (bf16*)(ws + WS_WSHD_T), 256, 1 << 30, 0, 0, scr, gw, NGW, lane);
    float* MOD = (float*)(ws + WS_CTL) + CW_MOD; LAS float* part = (LAS float*)(lds + 16384); LAS float* sc_ = (LAS float*)lds;
    __syncthreads();
    if (vcu < 96) { for (int i = tid; i < 4096; i += NTHR) { const float cv = in.c[i]; sc_[i] = cv * sigmoidf_(cv); } }
    __syncthreads();
    for (int jb = vcu; jb < 96; jb += G) { const int j = jb * 64 + lane;
        float a0 = 0.f, a1 = 0.f, a2 = 0.f, a3 = 0.f;
#pragma unroll 16
        for (int k = wave * 128; k < wave * 128 + 128; ++k) { const float w = in.w_ada[(size_t)k * 6144 + j];
            a0 += sc_[k] * w; a1 += sc_[1024 + k] * w; a2 += sc_[2048 + k] * w; a3 += sc_[3072 + k] * w; }
        part[(wave * 4 + 0) * 64 + lane] = a0; part[(wave * 4 + 1) * 64 + lane] = a1; part[(wave * 4 + 2) * 64 + lane] = a2; part[(wave * 4 + 3) * 64 + lane] = a3;
        __syncthreads();
        if (wave < 4) { float sum = in.b_ada[j];
#pragma unroll
            for (int w2 = 0; w2 < 8; ++w2) sum += part[(w2 * 4 + wave) * 64 + lane];
            MOD[wave * 6144 + j] = sum; }
        __syncthreads(); }
    bf16* WG = (bf16*)(ws + WS_WG_T);
    for (int idx = vcu * NTHR + tid; idx < 2048 * 256; idx += G * NTHR) { const int row = idx >> 8, kk = idx & 255, pn = row >> 8, within = row & 255, type = within >> 7, e = within & 127;
        float v = 0.f; if ((kk >> 7) == (pn & 1)) v = (type ? in.w_rg_x : in.w_rg_a)[((size_t)pn * 128 + (kk & 127)) * 128 + e];
        WG[idx] = (bf16)(cvt_pk_bf16(v, 0.f) & 0xffffu); }
    { float* SPL = (float*)(ws + WS_SPL); for (int i = vcu * NTHR + tid; i < 1024; i += G * NTHR) SPL[i] = -8.0f * LOG2E * log1pf(__expf(-in.lru_lambda[i])); }
    u32x4* z = (u32x4*)(ws + WS_WRT_T + 64 * 1024 * 2);
    for (int i = vcu * NTHR + tid; i < 192 * 1024 * 2 / 16; i += G * NTHR) z[i] = (u32x4){0u, 0u, 0u, 0u};
}

__device__ __forceinline__ void p1_norm_rows(const In& in, unsigned char* ws, int vcu, int G) {
    const int tid = threadIdx.x, lane = tid & 63, wave = __builtin_amdgcn_readfirstlane(tid >> 6);
    const int gw = vcu * NWAVES + wave, NGW = G * NWAVES;
    const float* MOD = (const float*)(ws + WS_CTL) + CW_MOD; bf16* H = (bf16*)(ws + WS_H);
    for (int m0 = gw; m0 < NTOK; m0 += 2 * NGW) {
        f32x4 v[2][4]; int mr[2];
#pragma unroll
        for (int q = 0; q < 2; ++q) { mr[q] = (m0 + q * NGW < NTOK) ? m0 + q * NGW : m0; const f32x4* xr = (const f32x4*)(in.x + (size_t)mr[q] * DM) + lane;
#pragma unroll
            for (int j = 0; j < 4; ++j) v[q][j] = xr[64 * j]; }
#pragma unroll
        for (int q = 0; q < 2; ++q) { const int mrow = mr[q], b = mrow >> 13; float s2 = 0.f;
#pragma unroll
            for (int j = 0; j < 4; ++j) s2 += (v[q][j].x * v[q][j].x + v[q][j].y * v[q][j].y) + (v[q][j].z * v[q][j].z + v[q][j].w * v[q][j].w);
            const float rstd = 1.0f / sqrtf(wave_sum(s2) * (1.f / DM) + EPSN);
            u64* o8 = (u64*)(H + (size_t)mrow * DM) + lane;
#pragma unroll
            for (int j = 0; j < 4; ++j) { const int col = 256 * j + 4 * lane; const f32x4 g = *(const f32x4*)(in.norm_gain + col), sh = *(const f32x4*)(MOD + b * 6144 + col), sc = *(const f32x4*)(MOD + b * 6144 + 1024 + col);
                const f32x4 r = (v[q][j] * rstd * g) * (sc + 1.0f) + sh; o8[64 * j] = (u64)cvt_pk_bf16(r.x, r.y) | ((u64)cvt_pk_bf16(r.z, r.w) << 32);
                ((unsigned*)(ws + WS_H8 + (size_t)mrow * DM))[64 * j + lane] = cvt4_fp8(clamp_e4m3(r.x), clamp_e4m3(r.y), clamp_e4m3(r.z), clamp_e4m3(r.w)); } } }
}

__device__ __forceinline__ void p3_conv(const In& in, unsigned char* ws, int vcu, int G) {
    const int gt = vcu * NTHR + threadIdx.x, NT = G * NTHR;
    const bf16* U = (const bf16*)(ws + WS_URNN); bf16* XC = (bf16*)(ws + WS_XC);
    const bool fixed_ch = (NT % 128) == 0; const int ch0 = (gt & 127) * 8;
    float cw[4][8], cb[8];
#pragma unroll
    for (int j = 0; j < 8; ++j) { cb[j] = in.conv_b[ch0 + j];
#pragma unroll
        for (int k = 0; k < 4; ++k) cw[k][j] = in.conv_w[k * 1024 + ch0 + j]; }
    for (int it = gt; it < NTOK * 128; it += NT) { const int row = it >> 7, ch = (it & 127) * 8, t = row & (SEQ - 1);
        if (!fixed_ch) {
#pragma unroll
            for (int j = 0; j < 8; ++j) { cb[j] = in.conv_b[ch + j];
#pragma unroll
                for (int k = 0; k < 4; ++k) cw[k][j] = in.conv_w[k * 1024 + ch + j]; } }
        u32x4 uu[4];
#pragma unroll
        for (int k = 0; k < 4; ++k) uu[k] = (t - 3 + k >= 0) ? *(const u32x4*)(U + (size_t)(row - 3 + k) * 1024 + ch) : (u32x4){0u, 0u, 0u, 0u};
        float a[8];
#pragma unroll
        for (int j = 0; j < 8; ++j) a[j] = cb[j];
#pragma unroll
        for (int k = 0; k < 4; ++k) { f32x4 u0, u1; unpack8(uu[k], u0, u1);
#pragma unroll
            for (int j = 0; j < 4; ++j) { a[j] += cw[k][j] * u0[j]; a[4 + j] += cw[k][4 + j] * u1[j]; } }
        *(u32x4*)(XC + (size_t)row * 1024 + ch) = pack8((f32x4){a[0], a[1], a[2], a[3]}, (f32x4){a[4], a[5], a[6], a[7]}); }
}

constexpr int SCH = 64, NCH = SEQ / SCH;
__device__ __forceinline__ void p5_scan_local(unsigned char* ws, int vcu, int G) {
    const int gt = vcu * NTHR + threadIdx.x, NT = G * NTHR;
    const bf16* LA = (const bf16*)(ws + WS_LOGA); const bf16* BBp = (const bf16*)(ws + WS_BB); float* CHA = (float*)(ws + WS_CHA); float* CHH = (float*)(ws + WS_CHH);
    for (int it = gt; it < NB * NCH * 256; it += NT) { const int cq = it & 255, bc = it >> 8; const size_t base = (size_t)bc * SCH * 1024 + cq * 4;
        f32x4 h = {0.f, 0.f, 0.f, 0.f}, sl = {0.f, 0.f, 0.f, 0.f};
#pragma unroll 8
        for (int r = 0; r < SCH; ++r) { const u32x2 la = *(const u32x2*)(LA + base + (size_t)r * 1024), bb = *(const u32x2*)(BBp + base + (size_t)r * 1024);
            const f32x4 l = {bf_lo(la.x), bf_hi(la.x), bf_lo(la.y), bf_hi(la.y)}, bv = {bf_lo(bb.x), bf_hi(bb.x), bf_lo(bb.y), bf_hi(bb.y)};
#pragma unroll
            for (int j = 0; j < 4; ++j) { const float a = fast_exp2(l[j]); h[j] = a * h[j] + __builtin_amdgcn_sqrtf(1.0f - a * a) * bv[j]; sl[j] += l[j]; } }
        *(f32x4*)(CHA + (size_t)it * 4) = sl; *(f32x4*)(CHH + (size_t)it * 4) = h; }
}
__device__ __forceinline__ void p7_scan_final(unsigned char* ws, int vcu, int G) {
    const int gt = vcu * NTHR + threadIdx.x, NT = G * NTHR;
    const bf16* LA = (const bf16*)(ws + WS_LOGA); const bf16* BBp = (const bf16*)(ws + WS_BB); const bf16* GG = (const bf16*)(ws + WS_GGATE); bf16* Y = (bf16*)(ws + WS_YRNN);
    const float* CHA = (const float*)(ws + WS_CHA); const float* CHH = (const float*)(ws + WS_CHH);
    for (int it = gt; it < NB * NCH * 256; it += NT) { const int cq = it & 255, bc = it >> 8, ch = bc & (NCH - 1), b = bc / NCH; const size_t base = (size_t)bc * SCH * 1024 + cq * 4;
        f32x4 h = {0.f, 0.f, 0.f, 0.f};
        for (int c0 = 0; c0 < ch; c0 += 8) { f32x4 av[8], hv[8];
#pragma unroll
            for (int u = 0; u < 8; ++u) { const int c2 = (c0 + u < ch) ? c0 + u : ch - 1; const size_t o = ((size_t)(b * NCH + c2) * 256 + cq) * 4; av[u] = *(const f32x4*)(CHA + o); hv[u] = *(const f32x4*)(CHH + o); }
#pragma unroll
            for (int u = 0; u < 8; ++u) if (c0 + u < ch) {
#pragma unroll
                for (int j = 0; j < 4; ++j) h[j] = fast_exp2(av[u][j]) * h[j] + hv[u][j]; } }
#pragma unroll 8
        for (int r = 0; r < SCH; ++r) { const size_t o = base + (size_t)r * 1024; const u32x2 la = *(const u32x2*)(LA + o), bb = *(const u32x2*)(BBp + o), gg = *(const u32x2*)(GG + o);
            const f32x4 l = {bf_lo(la.x), bf_hi(la.x), bf_lo(la.y), bf_hi(la.y)}, bv = {bf_lo(bb.x), bf_hi(bb.x), bf_lo(bb.y), bf_hi(bb.y)}, gv = {bf_lo(gg.x), bf_hi(gg.x), bf_lo(gg.y), bf_hi(gg.y)};
#pragma unroll
            for (int j = 0; j < 4; ++j) { const float a = fast_exp2(l[j]); h[j] = a * h[j] + __builtin_amdgcn_sqrtf(1.0f - a * a) * bv[j]; }
            u32x2 w; w.x = cvt_pk_bf16(h[0] * gv[0], h[1] * gv[1]); w.y = cvt_pk_bf16(h[2] * gv[2], h[3] * gv[3]); *(u32x2*)(Y + o) = w; } }
}

__device__ __forceinline__ void p13_mid(const In& in, unsigned char* ws, float* out, LAS unsigned char* lds, int vcu, int G) {
    const int tid = threadIdx.x, lane = tid & 63, wave = __builtin_amdgcn_readfirstlane(tid >> 6);
    const int gw = vcu * NWAVES + wave, NGW = G * NWAVES;
    const float* MOD = (const float*)(ws + WS_CTL) + CW_MOD; const bf16* Y1 = (const bf16*)(ws + WS_Y1); bf16* H2 = (bf16*)(ws + WS_H2);
    for (int m0 = gw; m0 < NTOK; m0 += 2 * NGW) {
        f32x4 v[2][4], xv[2][4]; int mr[2];
#pragma unroll
        for (int q = 0; q < 2; ++q) { mr[q] = (m0 + q * NGW < NTOK) ? m0 + q * NGW : m0;
            const u32x2* yr = (const u32x2*)(Y1 + (size_t)mr[q] * DM) + lane; const f32x4* xr = (const f32x4*)(in.x + (size_t)mr[q] * DM) + lane;
#pragma unroll
            for (int j = 0; j < 4; ++j) { const u32x2 w = yr[64 * j]; v[q][j] = (f32x4){bf_lo(w.x), bf_hi(w.x), bf_lo(w.y), bf_hi(w.y)}; xv[q][j] = xr[64 * j]; } }
#pragma unroll
        for (int q = 0; q < 2; ++q) { const int mrow = mr[q], b = mrow >> 13; float s2 = 0.f;
            if (q == 1 && m0 + NGW >= NTOK) continue;
#pragma unroll
            for (int j = 0; j < 4; ++j) s2 += (v[q][j].x * v[q][j].x + v[q][j].y * v[q][j].y) + (v[q][j].z * v[q][j].z + v[q][j].w * v[q][j].w);
            const float rstd = 1.0f / sqrtf(wave_sum(s2) * (1.f / DM) + EPSN); float s3 = 0.f;
            f32x4* o4 = (f32x4*)(out + (size_t)mrow * DM) + lane;
#pragma unroll
            for (int j = 0; j < 4; ++j) { const int col = 256 * j + 4 * lane; const f32x4 g = *(const f32x4*)(in.norm_gain + 1024 + col), gm = *(const f32x4*)(MOD + b * 6144 + 2048 + col);
                v[q][j] = xv[q][j] + gm * (v[q][j] * rstd * g); o4[64 * j] = v[q][j]; s3 += (v[q][j].x * v[q][j].x + v[q][j].y * v[q][j].y) + (v[q][j].z * v[q][j].z + v[q][j].w * v[q][j].w); }
            const float rstd2 = 1.0f / sqrtf(wave_sum(s3) * (1.f / DM) + EPSN);
            u64* o8 = (u64*)(H2 + (size_t)mrow * DM) + lane;
#pragma unroll
            for (int j = 0; j < 4; ++j) { const int col = 256 * j + 4 * lane; const f32x4 g = *(const f32x4*)(in.norm_gain + 2048 + col), sh = *(const f32x4*)(MOD + b * 6144 + 3072 + col), sc = *(const f32x4*)(MOD + b * 6144 + 4096 + col);
                const f32x4 r = (v[q][j] * rstd2 * g) * (sc + 1.0f) + sh; o8[64 * j] = (u64)cvt_pk_bf16(r.x, r.y) | ((u64)cvt_pk_bf16(r.z, r.w) << 32);
                ((unsigned*)(ws + WS_H2F8 + (size_t)mrow * DM))[64 * j + lane] = cvt4_fp8(clamp_e4m3(r.x), clamp_e4m3(r.y), clamp_e4m3(r.z), clamp_e4m3(r.w)); } } }
    LAS float* scr = (LAS float*)(lds + wave * 16384);
    for (int it = gw; it < NEXP * 384; it += NGW) { const int e = it / 384, r = it % 384, which = r >> 7, sub = r & 127;
        if (which == 0) tr_item_fp8(in.w_exp_gate + (size_t)e * 1024 * 256, 256, 256, (unsigned char*)(ws + WS_WEGU8) + (size_t)e * 512 * 1024, 1024, 128, 256, 0, 32.0f, scr, sub >> 3, sub & 7, lane);
        else if (which == 1) tr_item_fp8(in.w_exp_up + (size_t)e * 1024 * 256, 256, 256, (unsigned char*)(ws + WS_WEGU8) + (size_t)e * 512 * 1024, 1024, 128, 256, 128, 32.0f, scr, sub >> 3, sub & 7, lane);
        else tr_item_fp8(in.w_exp_down + (size_t)e * 256 * 1024, 1024, 1024, (unsigned char*)(ws + WS_WED8) + (size_t)e * 1024 * 256, 256, 1 << 30, 0, 0, 32.0f, scr, sub >> 5, sub & 31, lane); }
}

__device__ __forceinline__ void route_tile(const In& in, unsigned char* ws, int t0, int wave, int lane, unsigned& mycount) {
    const float* LG = (const float*)(ws + WS_LOGITS); int* SEL = (int*)(ws + WS_TOKSEL); float* TW = (float*)(ws + WS_TOKW);
    const float rb = in.router_bias[lane];
    float lg[4];
    for (int tok = t0 + wave, i4 = 0; tok < t0 + 256; tok += NWAVES, i4 = (i4 + 1) & 3) {
        if (i4 == 0) {
#pragma unroll
            for (int u = 0; u < 4; ++u) lg[u] = LG[(size_t)(tok + u * NWAVES < t0 + 256 ? tok + u * NWAVES : tok) * 64 + lane]; }
        const float lgc = i4 == 0 ? lg[0] : (i4 == 1 ? lg[1] : (i4 == 2 ? lg[2] : lg[3]));
        const float s = 1.0f / (1.0f + __expf(-lgc)), ss = s + rb;
        int rk8 = 0;
#pragma unroll
        for (int j = 0; j < 8; ++j) { const float o = __shfl(ss, (lane & ~7) + j); rk8 += (o > ss || (o == ss && j < (lane & 7))) ? 1 : 0; }
        float gsum = rk8 < 2 ? ss : 0.f; gsum += __shfl_xor(gsum, 1); gsum += __shfl_xor(gsum, 2); gsum += __shfl_xor(gsum, 4);
        int rkg = 0; const int g = lane >> 3;
#pragma unroll
        for (int j = 0; j < 8; ++j) { const float o = __shfl(gsum, 8 * j); rkg += (o > gsum || (o == gsum && j < g)) ? 1 : 0; }
        const float msk = rkg < 4 ? ss : -INFINITY;
        int rk = 0;
#pragma unroll
        for (int j = 0; j < 64; ++j) { const float o = __builtin_bit_cast(float, __builtin_amdgcn_readlane(__builtin_bit_cast(int, msk), j)); rk += (o > msk || (o == msk && j < lane)) ? 1 : 0; }
        const bool sel = rk < 8;
        const float wsum = wave_sum(sel ? s : 0.f);
        if (sel) { SEL[(size_t)tok * 8 + rk] = lane; TW[(size_t)tok * 8 + rk] = s * 2.5f / wsum; ++mycount; }
    }
}

__device__ __forceinline__ void p16_fill(unsigned char* ws, LAS unsigned char* lds, int vcu, int G) {
    int tid = threadIdx.x; asm volatile("" : "+v"(tid));
    LAS unsigned* hist = (LAS unsigned*)lds; LAS unsigned* basev = hist + 64; LAS unsigned* pstart = hist + 128; LAS unsigned* cnts = hist + 256;
    unsigned* CTL = (unsigned*)(ws + WS_CTL); const int* SEL = (const int*)(ws + WS_TOKSEL); const float* TW = (const float*)(ws + WS_TOKW);
    int* LT = (int*)(ws + WS_LISTTOK); float* LW = (float*)(ws + WS_LISTW); int* TE = (int*)(ws + WS_TILEE); int* LP = (int*)(ws + WS_LISTP);
    if (tid < 64) { hist[tid] = 0u; cnts[tid] = CTL[CW_CNT + tid]; }
    __syncthreads();
    if (tid == 0) { unsigned acc = 0; for (int e = 0; e < 64; ++e) { pstart[e] = acc; acc += (cnts[e] + 255u) & ~255u; } pstart[64] = acc; }
    __syncthreads();
    if (vcu == 0) {
        if (tid == 0) CTL[CW_NT] = pstart[64] >> 8;
        for (int e = tid >> 3; e < 64; e += 64) { for (unsigned p = pstart[e] + cnts[e] + (tid & 7); p < pstart[e + 1]; p += 8) { LT[p] = 0; LW[p] = 0.f; LP[p] = -1; } }
        for (unsigned t = tid; t < (pstart[64] >> 8); t += NTHR) { int e = 0; for (int q = 0; q < 64; ++q) if ((t << 8) >= pstart[q]) e = q; TE[t] = e; }
    }
    const int per = (NTOK + G - 1) / G, t0 = vcu * per, t1 = (t0 + per < NTOK) ? t0 + per : NTOK;
    for (int p = t0 * 8 + tid; p < t1 * 8; p += NTHR) lds_add(&hist[SEL[p]], 1u);
    __syncthreads();
    if (tid < 64) { basev[tid] = hist[tid] ? atomicAdd(CTL + CW_CUR + tid, hist[tid]) : 0u; }
    __syncthreads();
    if (tid < 64) hist[tid] = 0u;
    __syncthreads();
    for (int p = t0 * 8 + tid; p < t1 * 8; p += NTHR) { const int e = SEL[p]; const unsigned slot = pstart[e] + basev[e] + lds_add(&hist[e], 1u); LT[slot] = p >> 3; LW[slot] = TW[p]; LP[slot] = p; }
    __syncthreads();
}

__device__ __forceinline__ void p19_final(const In& in, unsigned char* ws, float* out, int vcu, int G) {
    const int tid = threadIdx.x, lane = tid & 63, wave = __builtin_amdgcn_readfirstlane(tid >> 6);
    const int gw = vcu * NWAVES + wave, NGW = G * NWAVES;
    const float* MOD = (const float*)(ws + WS_CTL) + CW_MOD;
    for (int mrow = gw; mrow < NTOK; mrow += NGW) { const int b = mrow >> 13;
        const u32x2* yr = (const u32x2*)((const bf16*)(ws + WS_Y2) + (size_t)mrow * DM) + lane; f32x4 v[4]; float s2 = 0.f;
#pragma unroll
        for (int j = 0; j < 4; ++j) { const u32x2 w = yr[64 * j]; v[j] = (f32x4){bf_lo(w.x), bf_hi(w.x), bf_lo(w.y), bf_hi(w.y)}; }
        f32x4* o4 = (f32x4*)(out + (size_t)mrow * DM) + lane; f32x4 x1v[4];
#pragma unroll
        for (int j = 0; j < 4; ++j) x1v[j] = o4[64 * j];
        { unsigned sv[8][4];
#pragma unroll
          for (int k = 0; k < 8; ++k) { const unsigned* sr = (const unsigned*)slot_row(ws, mrow * 8 + k) + lane;
#pragma unroll
              for (int j = 0; j < 4; ++j) sv[k][j] = sr[64 * j]; }
#pragma unroll
          for (int j = 0; j < 4; ++j) { f32x4 rs = {0.f, 0.f, 0.f, 0.f};
#pragma unroll
              for (int k = 0; k < 8; ++k) { rs[0] += __builtin_amdgcn_cvt_f32_fp8((int)sv[k][j], 0); rs[1] += __builtin_amdgcn_cvt_f32_fp8((int)sv[k][j], 1); rs[2] += __builtin_amdgcn_cvt_f32_fp8((int)sv[k][j], 2); rs[3] += __builtin_amdgcn_cvt_f32_fp8((int)sv[k][j], 3); }
              v[j] = v[j] + rs * 0.125f; } }
#pragma unroll
        for (int j = 0; j < 4; ++j) s2 += (v[j].x * v[j].x + v[j].y * v[j].y) + (v[j].z * v[j].z + v[j].w * v[j].w);
        const float rstd = 1.0f / sqrtf(wave_sum(s2) * (1.f / DM) + EPSN);
#pragma unroll
        for (int j = 0; j < 4; ++j) { const int col = 256 * j + 4 * lane; const f32x4 g = *(const f32x4*)(in.norm_gain + 3072 + col), gf = *(const f32x4*)(MOD + b * 6144 + 5120 + col);
            o4[64 * j] = x1v[j] + gf * (v[j] * rstd * g); } }
}

__device__ __forceinline__ int crow(int r, int hi) { return (r & 3) + 8 * (r >> 2) + 4 * hi; }
constexpr int IX_QS = 0, IX_H1 = 69632, IX_H2 = 102400, IX_TAB = 135168, IX_WL = 138240;

__device__ __forceinline__ void lds_inc(LAS unsigned* p) { (void)__hip_atomic_fetch_add(p, 1u, __ATOMIC_RELAXED, __HIP_MEMORY_SCOPE_WORKGROUP); }
__device__ __forceinline__ unsigned suffix_incl(unsigned v, int lane) {
#pragma unroll
    for (int off = 1; off < 64; off <<= 1) { const unsigned t = __shfl_down(v, off); if (lane + off < 64) v += t; }
    return v;
}
__device__ __forceinline__ void find_bins(LAS unsigned* hist, int wave, int lane, const int (&need)[4], LAS int* out_bin, LAS int* out_above) {
#pragma unroll
    for (int qq = 0; qq < 4; ++qq) { const int q = wave * 4 + qq;
        unsigned cj[4]; unsigned tot = 0;
#pragma unroll
        for (int j = 0; j < 4; ++j) { cj[j] = hist[(4 * lane + j) * 32 + q]; tot += cj[j]; }
        unsigned cum = suffix_incl(tot, lane) - tot;
#pragma unroll
        for (int j = 3; j >= 0; --j) { if ((int)cum < need[qq] && (int)(cum + cj[j]) >= need[qq]) { out_bin[q] = 4 * lane + j; out_above[q] = (int)cum; } cum += cj[j]; } }
}

__device__ __forceinline__ void p8_indexer(unsigned char* ws, LAS unsigned char* lds, int vcu, int G) {
    const int wave = __builtin_amdgcn_readfirstlane(threadIdx.x >> 6);
    const bf16* QI = (const bf16*)(ws + WS_QI); const bf16* KI = (const bf16*)(ws + WS_KI); const float* WI = (const float*)(ws + WS_WI);
    unsigned* SCR = (unsigned*)(ws + WS_SCR) + (size_t)vcu * 131072;
    LAS unsigned* H1 = (LAS unsigned*)(lds + IX_H1); LAS unsigned* H2 = (LAS unsigned*)(lds + IX_H2);
    LAS int* TB1 = (LAS int*)(lds + IX_TAB); LAS int* TAB = TB1 + 32; LAS int* TTHR = TB1 + 64; LAS int* TN3 = TB1 + 96; LAS int* TAB2 = TB1 + 128; LAS int* TV = TB1 + 160; LAS unsigned* CNT = (LAS unsigned*)(TB1 + 192);
    const int nrounds = (1024 + G - 1) / G;
    for (int rnd = 0; rnd < nrounds; ++rnd) {
        int tid = threadIdx.x; asm volatile("" : "+v"(tid));
        const int lane = tid & 63, c = lane & 31, hi = lane >> 5;
        const int ui = rnd * G + ((rnd & 1) ? (G - 1 - vcu) : vcu);
        if (ui >= 1024) continue;
        const int qg = 255 - (ui >> 2), b = ui & 3, t0 = qg * 32; const size_t rowbase = (size_t)b * SEQ;
        unsigned* MK = (unsigned*)(ws + WS_MASK) + ((size_t)(b * 256 + qg) * 128) * 64;
        if (qg < 8) {
            if (wave == 0) {
                for (int j = 0; j < 4; ++j) { unsigned W = 0u;
#pragma unroll
                    for (int r = 0; r < 16; ++r) { const int k0 = 64 * j + crow(r, hi), k1 = k0 + 32; W |= (k0 <= t0 + c ? 1u : 0u) << r; W |= (k1 <= t0 + c ? 1u : 0u) << (16 + r); }
                    unsigned ow = 0u;
#pragma unroll
                    for (int m = 0; m < 32; ++m) { const unsigned long long B = __ballot((W >> m) & 1u); const unsigned v = (lane & 1) ? (unsigned)(B >> 32) : (unsigned)B; ow = ((lane >> 1) == m) ? v : ow; }
                    MK[j * 64 + lane] = ow; }
            }
            continue;
        }
#pragma unroll
        for (int i = 0; i < 8; ++i) { const int j = tid + 512 * i, n = j & 31, rest = j >> 5, g = rest & 1, ks = (rest >> 1) & 3, h = rest >> 3;
            const u32x4 v = *(const u32x4*)(QI + (rowbase + t0 + n) * 1024 + h * 64 + ks * 16 + g * 8);
            *(LAS u32x4*)(lds + IX_QS + ((h * 4 + ks) * 2 + g) * 512 + n * 16) = v; }
#pragma unroll
        for (int i = 0; i < 32; ++i) H1[tid + 512 * i] = 0u;
        ((LAS float*)(lds + IX_WL))[tid] = WI[(rowbase + t0 + (tid & 31)) * 16 + (tid >> 5)];
        __syncthreads();
        { const int n = tid & 31, d0 = (tid >> 5) * 4, ks = d0 >> 4, g = (d0 >> 3) & 1;
            float a0 = 0.f, a1 = 0.f, a2 = 0.f, a3 = 0.f;
#pragma unroll
            for (int h = 0; h < 16; ++h) { const float w = WI[(rowbase + t0 + n) * 16 + h]; const u32x2 qv = *(const LAS u32x2*)(lds + IX_QS + ((h * 4 + ks) * 2 + g) * 512 + n * 16 + (d0 & 7) * 2);
                a0 += w * bf_lo(qv.x); a1 += w * bf_hi(qv.x); a2 += w * bf_lo(qv.y); a3 += w * bf_hi(qv.y); }
            u32x2 o; o.x = cvt_pk_bf16(a0, a1); o.y = cvt_pk_bf16(a2, a3);
            *(LAS u32x2*)(lds + IX_QS + ((16 * 4 + ks) * 2 + g) * 512 + n * 16 + (d0 & 7) * 2) = o; }
        __syncthreads();
        const int ngroups = (qg >> 2) + 1;
        for (int it = wave; it < ngroups; it += 8) {
            bf16x8 kf[4][4];
#pragma unroll
            for (int tile = 0; tile < 4; ++tile) { const int kt = 4 * it + tile, ktc = kt < qg ? kt : qg;
#pragma unroll
                for (int ks = 0; ks < 4; ++ks) kf[tile][ks] = *(const bf16x8*)(KI + (rowbase + 32 * ktc + c) * 64 + ks * 16 + hi * 8); }
            f32x16 sc[4];
#pragma unroll
            for (int tile = 0; tile < 4; ++tile)
#pragma unroll
                for (int r = 0; r < 16; ++r) sc[tile][r] = 0.f;
            bf16x8 bq[2][4]; f32x16 av[2]; float wq[2];
#define IX_LDQ(h_) do { _Pragma("unroll") for (int ks = 0; ks < 4; ++ks) bq[(h_) & 1][ks] = *(const LAS bf16x8*)(lds + IX_QS + (((h_) * 4 + ks) * 2 + hi) * 512 + c * 16); \
            wq[(h_) & 1] = ((const LAS float*)(lds + IX_WL))[((h_) & 15) * 32 + c]; } while (0)
            IX_LDQ(0);
#define IX_STEP(st) do { constexpr int h = (st) >> 1, pair = (st) & 1; \
                if (pair == 0 && h + 1 < 17) IX_LDQ(h + 1); \
                _Pragma("unroll") for (int r = 0; r < 16; ++r) { av[0][r] = 0.f; av[1][r] = 0.f; } \
                _Pragma("unroll") for (int ks = 0; ks < 4; ++ks) { av[0] = __builtin_amdgcn_mfma_f32_32x32x16_bf16(kf[2 * pair][ks], bq[h & 1][ks], av[0], 0, 0, 0); \
                    av[1] = __builtin_amdgcn_mfma_f32_32x32x16_bf16(kf[2 * pair + 1][ks], bq[h & 1][ks], av[1], 0, 0, 0); } \
                if (h < 16) { _Pragma("unroll") for (int r = 0; r < 16; ++r) { sc[2 * pair][r] = __builtin_fmaf(__builtin_fabsf(av[0][r]), wq[h & 1], sc[2 * pair][r]); sc[2 * pair + 1][r] = __builtin_fmaf(__builtin_fabsf(av[1][r]), wq[h & 1], sc[2 * pair + 1][r]); } } \
                else { _Pragma("unroll") for (int r = 0; r < 16; ++r) { sc[2 * pair][r] += av[0][r]; sc[2 * pair + 1][r] += av[1][r]; } } \
                __builtin_amdgcn_sched_barrier(0); } while (0)
#define IX_STEP2(s) IX_STEP((s)); IX_STEP((s) + 1)
            IX_STEP2(0); IX_STEP2(2); IX_STEP2(4); IX_STEP2(6); IX_STEP2(8); IX_STEP2(10); IX_STEP2(12); IX_STEP2(14); IX_STEP2(16);
            IX_STEP2(18); IX_STEP2(20); IX_STEP2(22); IX_STEP2(24); IX_STEP2(26); IX_STEP2(28); IX_STEP2(30); IX_STEP2(32);
#undef IX_STEP2
#undef IX_STEP
#undef IX_LDQ
            if (4 * it + 3 < qg) {
                asm volatile("; keys of a group below the diagonal" ::: "memory");
#pragma unroll
            for (int tile = 0; tile < 4; ++tile) { const int kt = 4 * it + tile;
#pragma unroll
                for (int rq = 0; rq < 2; ++rq) { u32x4 pq;
#pragma unroll
                    for (int j = 0; j < 4; ++j) { const int rp = 4 * rq + j, r0 = 2 * rp;
                        unsigned p = __builtin_bit_cast(unsigned, __builtin_amdgcn_cvt_pkrtz(sc[tile][r0], sc[tile][r0 + 1]));
                        p ^= 0x80008000u | __builtin_bit_cast(unsigned, __builtin_bit_cast(s16x2, p) >> (short)15);
                        lds_inc(H1 + ((p >> 8) & 255u) * 32 + c); lds_inc(H1 + (p >> 24) * 32 + c);
                        pq[j] = p; }
                    *(u32x4*)(SCR + ((size_t)((it * 8 + tile * 2 + rq) * 64 + lane)) * 4) = pq; } }
            } else {
                asm volatile("; keys of the diagonal group" ::: "memory");
#pragma unroll
            for (int tile = 0; tile < 4; ++tile) { const int kt = 4 * it + tile;
#pragma unroll
                for (int rq = 0; rq < 2; ++rq) { u32x4 pq;
#pragma unroll
                    for (int j = 0; j < 4; ++j) { const int rp = 4 * rq + j, r0 = 2 * rp;
                        unsigned p = __builtin_bit_cast(unsigned, __builtin_amdgcn_cvt_pkrtz(sc[tile][r0], sc[tile][r0 + 1]));
                        p ^= 0x80008000u | __builtin_bit_cast(unsigned, __builtin_bit_cast(s16x2, p) >> (short)15);
                        if (kt > qg) p = 0u;
                        else if (kt == qg) { if (crow(r0, hi) > c) p &= 0xffff0000u; if (crow(r0 + 1, hi) > c) p &= 0x0000ffffu; }
                        lds_inc(H1 + ((p >> 8) & 255u) * 32 + c); lds_inc(H1 + (p >> 24) * 32 + c);
                        pq[j] = p; }
                    *(u32x4*)(SCR + ((size_t)((it * 8 + tile * 2 + rq) * 64 + lane)) * 4) = pq; } }
            }
        }
        __syncthreads();
        int need[4];
#pragma unroll
        for (int qq = 0; qq < 4; ++qq) { const int nn = t0 + wave * 4 + qq + 1; need[qq] = nn < 256 ? nn : 256; }
        find_bins(H1, wave, lane, need, TB1, TAB);
        asm volatile("s_waitcnt vmcnt(0)" ::: "memory");
        __syncthreads();
        const unsigned b1 = (unsigned)TB1[c];
        for (int it = wave; it < ngroups; it += 8) { unsigned pv[32];
#pragma unroll
            for (int q4 = 0; q4 < 8; ++q4) { const u32x4 v4 = *(const u32x4*)(SCR + ((size_t)((it * 8 + q4) * 64 + lane)) * 4); pv[4 * q4] = v4.x; pv[4 * q4 + 1] = v4.y; pv[4 * q4 + 2] = v4.z; pv[4 * q4 + 3] = v4.w; }
#pragma unroll
            for (int s = 0; s < 32; ++s) { const unsigned p = pv[s];
                if (((p >> 8) & 255u) == b1) lds_inc(H2 + (p & 255u) * 32 + c);
                if ((p >> 24) == b1) lds_inc(H2 + ((p >> 16) & 255u) * 32 + c); } }
        __syncthreads();
        int need2[4];
#pragma unroll
        for (int qq = 0; qq < 4; ++qq) need2[qq] = need[qq] - TAB[wave * 4 + qq];
        find_bins(H2, wave, lane, need2, TV, TAB2);
        __syncthreads();
        const unsigned thr = (b1 << 8) | (unsigned)TV[c];
        const int needc = (t0 + c + 1) < 256 ? (t0 + c + 1) : 256;
        const int ties_take = needc - TAB[c] - TAB2[c];
        unsigned cnt = 0;
        for (int it = wave; it < ngroups; it += 8) { unsigned pv[32];
#pragma unroll
            for (int q4 = 0; q4 < 8; ++q4) { const u32x4 v4 = *(const u32x4*)(SCR + ((size_t)((it * 8 + q4) * 64 + lane)) * 4); pv[4 * q4] = v4.x; pv[4 * q4 + 1] = v4.y; pv[4 * q4 + 2] = v4.z; pv[4 * q4 + 3] = v4.w; }
#pragma unroll
            for (int s = 0; s < 32; ++s) { const unsigned p = pv[s]; cnt += ((p & 0xffffu) == thr) ? 1u : 0u; cnt += ((p >> 16) == thr) ? 1u : 0u; } }
        CNT[wave * 64 + lane] = cnt;
        __syncthreads();
        int rank = 0;
        for (int w2 = 0; w2 < wave; ++w2) rank += (int)(CNT[w2 * 64 + c] + CNT[w2 * 64 + 32 + c]);
        if (hi) rank += (int)CNT[wave * 64 + c];
        for (int it = wave; it < ngroups; it += 8) { unsigned pv[32];
#pragma unroll
            for (int q4 = 0; q4 < 8; ++q4) { const u32x4 v4 = *(const u32x4*)(SCR + ((size_t)((it * 8 + q4) * 64 + lane)) * 4); pv[4 * q4] = v4.x; pv[4 * q4 + 1] = v4.y; pv[4 * q4 + 2] = v4.z; pv[4 * q4 + 3] = v4.w; }
            unsigned W[2] = {0u, 0u};
#pragma unroll
            for (int tile = 0; tile < 4; ++tile) {
#pragma unroll
                for (int rp = 0; rp < 8; ++rp) { const unsigned p = pv[tile * 8 + rp];
                    const unsigned k0 = p & 0xffffu, k1 = p >> 16;
                    const bool s0 = k0 > thr || (k0 == thr && rank < ties_take); if (k0 == thr) ++rank;
                    const bool s1 = k1 > thr || (k1 == thr && rank < ties_take); if (k1 == thr) ++rank;
                    const unsigned long long B0 = __ballot(s0), B1 = __ballot(s1); const int m0 = (tile & 1) * 16 + 2 * rp;
                    const unsigned v0 = (lane & 1) ? (unsigned)(B0 >> 32) : (unsigned)B0, v1 = (lane & 1) ? (unsigned)(B1 >> 32) : (unsigned)B1;
                    W[tile >> 1] = ((lane >> 1) == m0) ? v0 : (((lane >> 1) == m0 + 1) ? v1 : W[tile >> 1]); } }
            MK[(2 * it) * 64 + lane] = W[0]; MK[(2 * it + 1) * 64 + lane] = W[1]; }
        __syncthreads();
    }
}

constexpr int AT_K = 0, AT_TB = 8192, AT_V = 4 * 8192, AT_BIAS = 8 * 8192;
__device__ __forceinline__ unsigned pk4_fp8(float a, float b, float c, float d) { int w = __builtin_amdgcn_cvt_pk_fp8_f32(a, b, 0, false); w = __builtin_amdgcn_cvt_pk_fp8_f32(c, d, w, true); return (unsigned)w; }
__device__ __forceinline__ unsigned pk4_fp8t(float a, float b, float c, float d) { int w = __builtin_amdgcn_cvt_pk_fp8_f32(a, b, __builtin_bit_cast(int, a), false); w = __builtin_amdgcn_cvt_pk_fp8_f32(c, d, w, true); return (unsigned)w; }
__device__ __forceinline__ pg8::i32x8 ld_frag8(const LAS unsigned char* base, int off) {
    const u32x4 a = *(const LAS u32x4*)(base + off), b = *(const LAS u32x4*)(base + (off ^ 16)); return (pg8::i32x8){(int)a.x, (int)a.y, (int)a.z, (int)a.w, (int)b.x, (int)b.y, (int)b.z, (int)b.w}; }
#define MFMA8(A, B, C) __builtin_amdgcn_mfma_scale_f32_32x32x64_f8f6f4(A, B, C, 0, 0, 0, 0, 0, 0)

__device__ __forceinline__ void p9_attention(const In& in, unsigned char* ws, LAS unsigned char* lds, int vcu, int G) {
    const int tid = threadIdx.x, lane = tid & 63, wave = __builtin_amdgcn_readfirstlane(tid >> 6), c = lane & 31, hi = lane >> 5;
    const unsigned char* Q = ws + WS_Q; const unsigned char* Kp = ws + WS_K; const unsigned char* VT = ws + WS_VT; unsigned char* YA = ws + WS_YATT;
    const unsigned* MASK = (const unsigned*)(ws + WS_MASK);
    LAS float* BIAS = (LAS float*)(lds + AT_BIAS);
    const float NEG = -INFINITY;
    const int nrounds = (1024 + G - 1) / G;
    for (int rnd = 0; rnd < nrounds; ++rnd) {
        int qb, bh;
        if (G == 256) {
            const int xcd = vcu >> 5, w5 = vcu & 31, p = w5 & 15; bh = (rnd >> 1) * 16 + xcd * 2 + (w5 >> 4); qb = (rnd & 1) ? p : 31 - p;
        } else { const int ui = rnd * G + ((rnd & 1) ? (G - 1 - vcu) : vcu); if (ui >= 1024) continue; qb = 31 - (ui >> 5); bh = ui & 31; }
        const int b = bh >> 3, h = bh & 7;
        __syncthreads();
        if (tid < 128) { int bk = tid; if (tid >= 16) { bk = 16 + (int)(__log2f((float)tid * 0.0625f) * 5.3333333f); bk = bk > 31 ? 31 : bk; } BIAS[tid] = LOG2E * in.rel_bias[bk * 8 + h]; }
        const float cfar = LOG2E * in.rel_bias[31 * 8 + h];
        const int tq0 = 256 * qb + 32 * wave, t = tq0 + c, qg = tq0 >> 5;
        pg8::i32x8 qf[2];
#pragma unroll
        for (int ks = 0; ks < 2; ++ks) { const u32x4* qp = (const u32x4*)(Q + ((size_t)(b * SEQ + t)) * 1024 + h * 128 + ks * 64 + hi * 32); const u32x4 x = qp[0], y = qp[1];
            qf[ks] = (pg8::i32x8){(int)x.x, (int)x.y, (int)x.z, (int)x.w, (int)y.x, (int)y.y, (int)y.z, (int)y.w}; }
        f32x16 oacc[4];
#pragma unroll
        for (int db = 0; db < 4; ++db)
#pragma unroll
            for (int r = 0; r < 16; ++r) oacc[db][r] = 0.f;
        float m_run = -1e30f, l_run = 0.f;
        const int ntile = 4 * (qb + 1);
        const int krow_ = 8 * wave + (lane >> 3), vrow_ = 16 * wave + (lane >> 2);
        const unsigned char* ksrc = Kp + ((size_t)(b * SEQ + krow_)) * 1024 + h * 128 + (((lane & 7) ^ ((krow_ >> 1) & 7)) * 16);
        const unsigned char* vsrc = VT + ((size_t)(h * 128 + vrow_)) * NTOK + b * SEQ + (((lane & 3) ^ ((vrow_ >> 2) & 3)) * 16);
#define AT_DMA(j, buf) do { \
            __builtin_amdgcn_global_load_lds((const unsigned*)(ksrc + (size_t)(64 * (j)) * 1024), (LAS unsigned*)(lds + AT_K + (buf) * AT_TB + wave * 1024), 16, 0, 0); \
            __builtin_amdgcn_global_load_lds((const unsigned*)(vsrc + 64 * (j)), (LAS unsigned*)(lds + AT_V + (buf) * AT_TB + wave * 1024), 16, 0, 0); } while (0)
        const unsigned long long* mrow = (const unsigned long long*)(MASK + (((size_t)(b * 256 + qg)) * 128) * 64);
        u64x8 mk0, mk1, mk2, mk3;
#define AT_MLOAD(j, dep) asm volatile("s_load_dwordx16 %0, %4, 0x0\n\ts_load_dwordx16 %1, %4, 0x40\n\ts_load_dwordx16 %2, %4, 0x80\n\ts_load_dwordx16 %3, %4, 0xc0" \
            : "=&s"(mk0), "=&s"(mk1), "=&s"(mk2), "=&s"(mk3) : "s"(mrow + (size_t)(j) * 32), "v"(dep) : "memory")
        AT_MLOAD(0, tid);
#pragma unroll
        for (int ks = 0; ks < 2; ++ks) asm volatile("" :: "v"(qf[ks]));
        asm volatile("s_waitcnt vmcnt(0)" ::: "memory");
        AT_DMA(0, 0); AT_DMA(1, 1); AT_DMA(2, 2);
        asm volatile("s_waitcnt vmcnt(2)" ::: "memory");
        asm volatile("s_waitcnt lgkmcnt(0)" : "+s"(mk0), "+s"(mk1), "+s"(mk2), "+s"(mk3) :: "memory");
        __builtin_amdgcn_s_barrier();
        const int koff = c * 128 + (((2 * hi) ^ ((c >> 1) & 7)) << 4), voff = c * 64 + (((2 * hi) ^ ((c >> 2) & 3)) << 4);
        const int jw = (tq0 + 31) >> 6;
        pg8::i32x8 kf[4];
        kf[0] = ld_frag8(lds + AT_K, koff); kf[1] = ld_frag8(lds + AT_K, koff ^ 64); kf[2] = ld_frag8(lds + AT_K + 4096, koff); kf[3] = ld_frag8(lds + AT_K + 4096, koff ^ 64);
        for (int j = 0; j < ntile; ++j) {
            const int buf = j & 3;
            if (j <= jw) {
                f32x16 p0, p1;
                {
                    const f32x16 z = {0.f, 0.f, 0.f, 0.f, 0.f, 0.f, 0.f, 0.f, 0.f, 0.f, 0.f, 0.f, 0.f, 0.f, 0.f, 0.f};
                    p0 = MFMA8(kf[0], qf[0], z); p1 = MFMA8(kf[2], qf[0], z); p0 = MFMA8(kf[1], qf[1], p0); p1 = MFMA8(kf[3], qf[1], p1);
                }
                pg8::i32x8 vf[4];
                { const LAS unsigned char* vb = lds + AT_V + buf * AT_TB;
#pragma unroll
                  for (int db = 0; db < 4; ++db) vf[db] = ld_frag8(vb + db * 2048, voff); }
                if (j < jw) { const LAS unsigned char* kn = lds + AT_K + ((j + 1) & 3) * AT_TB;
                    kf[0] = ld_frag8(kn, koff); kf[1] = ld_frag8(kn, koff ^ 64); kf[2] = ld_frag8(kn + 4096, koff); kf[3] = ld_frag8(kn + 4096, koff ^ 64); }
                const int dmin = tq0 - (64 * j + 63);
                float boff = cfar;
                if (dmin < 113) { boff = 0.f;
#pragma unroll
                    for (int r = 0; r < 16; ++r) { int d0 = t - (64 * j + crow(r, hi)), d1 = d0 - 32; d0 = d0 < 0 ? 0 : (d0 > 127 ? 127 : d0); d1 = d1 < 0 ? 0 : (d1 > 127 ? 127 : d1); p0[r] += BIAS[d0]; p1[r] += BIAS[d1]; }
                }
                {
                    const float touch = p0[0] + p1[0];
#define AT_SELM(P, r, M) do { float o_; asm("v_cndmask_b32_e64 %0, %1, %2, %3" : "=v"(o_) : "v"(NEG), "v"(P[r]), "s"(M), "v"(touch)); P[r] = o_; } while (0)
#pragma unroll
                    for (int r = 0; r < 8; ++r) { AT_SELM(p0, r, mk0[r]); AT_SELM(p0, 8 + r, mk1[r]); AT_SELM(p1, r, mk2[r]); AT_SELM(p1, 8 + r, mk3[r]); }
#undef AT_SELM
                }
                float mx = fmaxf(fmaxf(p0[0], p0[1]), p1[0]);
#pragma unroll
                for (int r = 2; r < 16; r += 2) mx = fmaxf(fmaxf(mx, p0[r]), p0[r + 1]);
#pragma unroll
                for (int r = 1; r < 15; r += 2) mx = fmaxf(fmaxf(mx, p1[r]), p1[r + 1]);
                mx = fmaxf(mx, p1[15]);
                mx = fmaxf(mx, __shfl_xor(mx, 32)) + boff;
                AT_MLOAD(j + 1 < 128 ? j + 1 : 127, mx);
                const float m_new = (mx > m_run + 2.0f) ? mx : m_run, alpha = fast_exp2(m_run - m_new); m_run = m_new;
                const float sub = m_new - boff - 6.0f;
                const f32x2 ns2 = {-sub, -sub};
                f32x2 s2a = {0.f, 0.f}, s2b = {0.f, 0.f}, q[16];
#pragma unroll
                for (int i = 0; i < 8; ++i) { q[i] = (f32x2){p0[2 * i], p0[2 * i + 1]}; q[8 + i] = (f32x2){p1[2 * i], p1[2 * i + 1]}; }
#pragma unroll
                for (int i = 0; i < 16; i += 2) { f32x2 u = q[i], v = q[i + 1];
                    u = u + ns2; v = v + ns2;
                    u.x = fast_exp2(u.x); u.y = fast_exp2(u.y); v.x = fast_exp2(v.x); v.y = fast_exp2(v.y);
                    s2a = s2a + u; s2b = s2b + v;
                    q[i] = u; q[i + 1] = v; }
                l_run = l_run * alpha + ((s2a.x + s2b.x) + (s2a.y + s2b.y));
                if (!__all(alpha == 1.0f)) {
#pragma unroll
                    for (int db = 0; db < 4; ++db)
#pragma unroll
                        for (int r = 0; r < 16; ++r) oacc[db][r] *= alpha; }
                pg8::i32x8 pb;
#pragma unroll
                for (int i = 0; i < 4; ++i) { const unsigned a = pk4_fp8t(q[2 * i].x, q[2 * i].y, q[2 * i + 1].x, q[2 * i + 1].y), bq = pk4_fp8t(q[8 + 2 * i].x, q[8 + 2 * i].y, q[9 + 2 * i].x, q[9 + 2 * i].y);
                    const auto sw = __builtin_amdgcn_permlane32_swap(a, bq, false, false); pb[2 * i] = (int)sw[0]; pb[2 * i + 1] = (int)sw[1]; }
#pragma unroll
                for (int db = 0; db < 4; ++db) oacc[db] = MFMA8(vf[db], pb, oacc[db]);
            }
            if (j + 3 < ntile) AT_DMA(j + 3, (j + 3) & 3);
            if (j + 3 < ntile) asm volatile("s_waitcnt vmcnt(2)" ::: "memory"); else asm volatile("s_waitcnt vmcnt(0)" ::: "memory");
            asm volatile("s_waitcnt lgkmcnt(0)" ::: "memory");
            __builtin_amdgcn_s_barrier();
        }
        const float l = l_run + __shfl_xor(l_run, 32), inv = 1.0f / l;
        unsigned char* yrow = YA + ((size_t)(b * SEQ + t)) * 1024 + h * 128 + 16 * hi;
#pragma unroll
        for (int db = 0; db < 4; ++db) { unsigned w[4];
#pragma unroll
            for (int rg = 0; rg < 4; ++rg) w[rg] = pk4_fp8(clamp_e4m3(oacc[db][4 * rg] * inv), clamp_e4m3(oacc[db][4 * rg + 1] * inv), clamp_e4m3(oacc[db][4 * rg + 2] * inv), clamp_e4m3(oacc[db][4 * rg + 3] * inv));
            const auto sA = __builtin_amdgcn_permlane32_swap(w[0], w[2], false, false), sB = __builtin_amdgcn_permlane32_swap(w[1], w[3], false, false);
            *(u32x4*)(yrow + 32 * db) = (u32x4){sA[0], sA[1], sB[0], sB[1]}; }
#undef AT_DMA
#undef AT_MLOAD
    }
}

struct Args { In in; float* out; unsigned char* ws; int ph_lo, ph_hi; };
constexpr int N_PHASES = 20;

__global__ void __launch_bounds__(NTHR, 2) mk_fwd(Args args) {
    extern __shared__ __attribute__((aligned(16))) unsigned char lds_raw[];
    LAS unsigned char* lds = (LAS unsigned char*)lds_raw;
    const int tid = threadIdx.x;
    const int G = gridDim.x; int vcu; { const int bx = blockIdx.x; vcu = (G % 8 == 0) ? (bx % 8) * (G / 8) + bx / 8 : bx; }
    unsigned char* ws = args.ws; const In& in = args.in;
    volatile LAS unsigned* MISC = (volatile LAS unsigned*)(lds + LDSCTL_OFF);
    for (int u = tid; u < (LDS_BYTES - LDSCTL_OFF) / 4; u += NTHR) ((LAS unsigned*)(lds + LDSCTL_OFF))[u] = 0u;
    __syncthreads();
    XcdBarrier bar = xcd_barrier_post((unsigned*)(ws + WS_CTL) + CW_BAR, MISC + 8);
    const int lo = args.ph_lo, hi = args.ph_hi;
#ifdef ONLY
#define IN(k) ((k) == ONLY && lo <= (k) && (k) < hi)
#else
#define IN(k) (lo <= (k) && (k) < hi)
#endif
#define SEAM(k) do { if (IN(k) && IN((k) + 1)) xcd_barrier(bar); } while (0)
    const int cid = (int)blockIdx.x;

    if (IN(0)) { p0_prologue(in, ws, lds, vcu, G); } SEAM(0);
    if (IN(1)) { p1_norm_rows(in, ws, vcu, G); } SEAM(1);
    if (IN(2)) {
        pg8::DenseOrder S; S.init(ws + WS_H, ws + WS_WIN_T, NTOK, 2048, 1024, 1024, G, cid);
        EpiSplitBf16<0, 1> E{(bf16*)(ws + WS_URNN), (bf16*)(ws + WS_GGATE), 1024, 1024, 1.0f, 1.0f};
        pg8::gemm_phase<EpiSplitBf16<0, 1>, pg8::DenseOrder, true, true>(lds, pg8::Gemm{1024, 1024, 1024}, S, E);
    } SEAM(2);
    if (IN(3)) { p3_conv(in, ws, vcu, G); } SEAM(3);
    if (IN(4)) {
        pg8::DenseOrder S; S.init(ws + WS_XC, ws + WS_WG_T, NTOK, 2048, 1024, 256, G, cid); S.a_sh = 1; S.a_mul = 256 * 2;
        EpiGate E{(const bf16*)(ws + WS_XC), (bf16*)(ws + WS_LOGA), (bf16*)(ws + WS_BB), in.b_rg_a, in.b_rg_x, (const float*)(ws + WS_SPL)};
        pg8::gemm_phase<EpiGate, pg8::DenseOrder, true, true>(lds, pg8::Gemm{1024, 256, 256}, S, E);
    } SEAM(4);
    if (IN(5)) { p5_scan_local(ws, vcu, G); } SEAM(5);
    if (IN(6)) {
        p7_scan_final(ws, vcu, G);
        pg8::DenseOrder S; S.init(ws + WS_H, ws + WS_WIN_T + (size_t)C_QI * 1024 * 2, NTOK, 1280, 1024, 1024, G, cid);
        EpiIdx E{(bf16*)(ws + WS_QI), (bf16*)(ws + WS_KI), (float*)(ws + WS_WI)};
        pg8::gemm_phase<EpiIdx, pg8::DenseOrder, true, true>(lds, pg8::Gemm{1024, 1024, 1024}, S, E);
    } SEAM(6);
    if (IN(7)) { p8_indexer(ws, lds, vcu, G); } SEAM(7);
    if (IN(8)) {
        { pg8::DenseOrder8 S; S.init(ws + WS_H8, ws + WS_WQKV8, NTOK, 2048, 512, 512, G, cid);
          EpiSplitF8 E{ws + WS_Q, ws + WS_K, 1024, 1024, QSCALE / 32.0f, 1.0f / 32.0f};
          pg8::gemm_phase<EpiSplitF8, pg8::DenseOrder8, true, true>(lds, pg8::Gemm{512, 512, 512}, S, E); }
        { pg8::DenseOrder8 S; S.init(ws + WS_WQKV8 + (size_t)2048 * 1024, ws + WS_H8, 1024, NTOK, 512, 512, G, cid);
          EpiSplitF8 E{ws + WS_VT, ws + WS_VT, NTOK, 1 << 30, 1.0f / 32.0f, 1.0f / 32.0f};
          pg8::gemm_phase<EpiSplitF8, pg8::DenseOrder8, true, true>(lds, pg8::Gemm{512, 512, 512}, S, E); }
    } SEAM(8);
    if (IN(9)) { p9_attention(in, ws, lds, vcu, G); } SEAM(9);
    if (IN(11)) {
        { pg8::DenseOrder8 S; S.init(ws + WS_H8, ws + WS_WGL8, NTOK, 1024, 512, 512, G, cid);
          EpiSplitBf16<2, 2> E{(bf16*)(ws + WS_GLR), (bf16*)(ws + WS_GLR), 1024, 1 << 30, 1.0f / 32.0f, 1.0f / 32.0f};
          pg8::gemm_phase<EpiSplitBf16<2, 2>, pg8::DenseOrder8, true, true>(lds, pg8::Gemm{512, 512, 512}, S, E); }
        { pg8::DenseOrder8 S; S.init(ws + WS_H8, ws + WS_WGL8 + (size_t)1024 * 1024, NTOK, 1024, 512, 512, G, cid);
          EpiSplitBf16<2, 2> E{(bf16*)(ws + WS_GLA), (bf16*)(ws + WS_GLA), 1024, 1 << 30, 1.0f / 32.0f, 1.0f / 32.0f};
          pg8::gemm_phase<EpiSplitBf16<2, 2>, pg8::DenseOrder8, true, true>(lds, pg8::Gemm{512, 512, 512}, S, E); }
        asm volatile("s_waitcnt vmcnt(0)" ::: "memory"); __syncthreads();
        { pg8::DenseOrder S; S.init(ws + WS_YRNN, ws + WS_WBRR_T, NTOK, 1024, 1024, 1024, G, cid);
          EpiMerge<0> E{(bf16*)(ws + WS_M1), (const bf16*)(ws + WS_GLR), 1.0f};
          pg8::gemm_phase<EpiMerge<0>, pg8::DenseOrder, true, true>(lds, pg8::Gemm{1024, 1024, 1024}, S, E); }
        asm volatile("s_waitcnt vmcnt(0)" ::: "memory"); __syncthreads();
        { pg8::DenseOrder8 S; S.init(ws + WS_YATT, ws + WS_WBRA8, NTOK, 1024, 512, 512, G, cid);
          EpiMerge<1> E{(bf16*)(ws + WS_M1), (const bf16*)(ws + WS_GLA), 1.0f / 32.0f};
          pg8::gemm_phase<EpiMerge<1>, pg8::DenseOrder8, true, true>(lds, pg8::Gemm{512, 512, 512}, S, E); }
    } SEAM(11);
    if (IN(12)) {
        pg8::DenseOrder S; S.init(ws + WS_M1, ws + WS_WOUT_T, NTOK, 1024, 1024, 1024, G, cid);
        EpiBf16 E{(bf16*)(ws + WS_Y1), 1024};
        pg8::gemm_phase<EpiBf16, pg8::DenseOrder, true, true>(lds, pg8::Gemm{1024, 1024, 1024}, S, E);
    } SEAM(12);
    if (IN(13)) { p13_mid(in, ws, args.out, lds, vcu, G); } SEAM(13);
    if (IN(14)) {
        { pg8::DenseOrder SR; SR.init(ws + WS_H2, ws + WS_WRT_T, NTOK, 256, 1024, 1024, G, cid);
          EpiF32 E{(float*)(ws + WS_LOGITS), 64, 64};
          pg8::gemm_phase<EpiF32, pg8::DenseOrder, true, true>(lds, pg8::Gemm{1024, 1024, 1024}, SR, E); }
        asm volatile("s_waitcnt vmcnt(0)" ::: "memory"); __syncthreads();
        { int tid2 = threadIdx.x; asm volatile("" : "+v"(tid2)); const int lane2 = tid2 & 63, wave2 = __builtin_amdgcn_readfirstlane(tid2 >> 6);
          LAS unsigned* hist = (LAS unsigned*)lds; if (tid2 < 64) hist[tid2] = 0u; __syncthreads();
          unsigned mycount = 0;
          for (int L = cid; L < NTOK / 256; L += G) {
              const int xcd = L % 8, off = L / 8, wg = xcd * ((NTOK / 256) / 8) + off, pm = (wg / 8) * 8 + (wg % 8);
              route_tile(in, ws, pm * 256, wave2, lane2, mycount); }
          if (mycount) lds_add(&hist[lane2], mycount);
          __syncthreads();
          if (tid2 < 64 && hist[tid2]) atomicAdd((unsigned*)(ws + WS_CTL) + CW_CNT + tid2, hist[tid2]);
          __syncthreads(); }
        { pg8::DenseOrder S;
          if (G == 256) { S.init(ws + WS_H2, ws + WS_WSHGU_T, NTOK, 512, 1024, 1024, 128, cid >= 128 ? cid - 128 : 0); if (cid < 128) S.nwg = 0; }
          else S.init(ws + WS_H2, ws + WS_WSHGU_T, NTOK, 512, 1024, 1024, G, cid);
          EpiGlu E{(bf16*)(ws + WS_ACTSH), 1.0f};
          pg8::gemm_phase<EpiGlu, pg8::DenseOrder, true, true>(lds, pg8::Gemm{1024, 1024, 1024}, S, E); }
    } SEAM(14);
    if (IN(15)) {
        p16_fill(ws, lds, vcu, G);
        pg8::DenseOrder S; S.init(ws + WS_ACTSH, ws + WS_WSHD_T, NTOK, 1024, 256, 256, G, cid);
        EpiBf16 E{(bf16*)(ws + WS_Y2), 1024};
        pg8::gemm_phase<EpiBf16, pg8::DenseOrder, true, true>(lds, pg8::Gemm{256, 256, 256}, S, E);
    } SEAM(15);
    if (IN(17)) {
        const int ntiles = (int)((const unsigned*)(ws + WS_CTL))[CW_NT];
        MoeOrder<true, true> S{(const int*)(ws + WS_TILEE), (const int*)(ws + WS_LISTTOK), ntiles * 2, 2, 0, G, cid, (const char*)(ws + WS_H2F8), (const char*)(ws + WS_WEGU8), 0, (size_t)512 * 1024, (size_t)256 * 1024};
        EpiGlu8 E{(unsigned char*)(ws + WS_ACT8), 1.0f / 32.0f};
        pg8::gemm_phase<EpiGlu8, MoeOrder<true, true>, true, true>(lds, pg8::Gemm{512, 512, 512}, S, E);
    } SEAM(17);
    if (IN(18)) {
        const int ntiles = (int)((const unsigned*)(ws + WS_CTL))[CW_NT];
        MoeOrder<false, true> S{(const int*)(ws + WS_TILEE), (const int*)(ws + WS_LISTTOK), ntiles * 4, 4, 0, G, cid, (const char*)(ws + WS_ACT8), (const char*)(ws + WS_WED8), (size_t)256 * 256, (size_t)1024 * 256, (size_t)256 * 256};
        EpiSlot E{ws, (const int*)(ws + WS_LISTP), (const float*)(ws + WS_LISTW), 8.0f / 32.0f};
        pg8::gemm_phase<EpiSlot, MoeOrder<false, true>, true, true>(lds, pg8::Gemm{128, 128, 128}, S, E);
    } SEAM(18);
    if (IN(19)) { p19_final(in, ws, args.out, vcu, G); }
#undef IN
#undef SEAM
}

extern "C" void kernel_launch(void* const* d_in, const int* in_sizes, int n_in, void* d_out, int out_size, void* d_ws, size_t ws_size, hipStream_t stream) {
    static int grid = 0;
    if (grid == 0) {
        if (n_in != 25 || in_sizes[0] != NTOK * DM || out_size != NTOK * DM || ws_size < WS_NEED) { fprintf(stderr, "kernel_launch: unexpected shapes / workspace (%d inputs, ws %zu); nothing launched\n", n_in, ws_size); grid = -1; return; }
        int dev = 0, cus = 0;
        if (hipGetDevice(&dev) != hipSuccess || hipDeviceGetAttribute(&cus, hipDeviceAttributeMultiprocessorCount, dev) != hipSuccess) { grid = -1; return; }
        if (hipFuncSetAttribute((const void*)mk_fwd, hipFuncAttributeMaxDynamicSharedMemorySize, LDS_BYTES) != hipSuccess) { grid = -1; return; }
        int per_cu = 0;
        if (hipOccupancyMaxActiveBlocksPerMultiprocessor(&per_cu, (const void*)mk_fwd, NTHR, LDS_BYTES) != hipSuccess || per_cu < 1) { fprintf(stderr, "kernel_launch: occupancy query says %d\n", per_cu); (void)hipGetLastError(); }
        grid = cus > 256 ? 256 : cus;
    }
    if (grid < 0) return;
    (void)hipMemsetAsync((char*)d_ws + WS_CTL, 0, CTL_ZERO_BYTES, stream);
    Args a{};
    const float** ip = (const float**)&a.in;
    for (int i = 0; i < 25; ++i) ip[i] = (const float*)d_in[i];
    a.out = (float*)d_out; a.ws = (unsigned char*)d_ws;
    a.ph_lo = 0; a.ph_hi = N_PHASES;
    hipLaunchKernelGGL(mk_fwd, dim3(grid), dim3(NTHR), LDS_BYTES, stream, a);
}
```

```cpp
#include <hip/hip_runtime.h>
#include <cstdio>
#include <cstdint>
#include <type_traits>

#define LAS __attribute__((address_space(3)))
#define GAS __attribute__((address_space(1)))
typedef unsigned short bf16;
typedef short bf16x8 __attribute__((ext_vector_type(8)));
typedef float f32x4 __attribute__((ext_vector_type(4)));
typedef float f32x2 __attribute__((ext_vector_type(2)));
typedef float f32x16 __attribute__((ext_vector_type(16)));
typedef unsigned u32x4 __attribute__((ext_vector_type(4)));
typedef short s16x2 __attribute__((ext_vector_type(2)));
typedef unsigned long long u64x8 __attribute__((ext_vector_type(8)));
typedef unsigned u32x2 __attribute__((ext_vector_type(2)));
typedef __bf16 bf16x2_t __attribute__((ext_vector_type(2)));
typedef unsigned long long u64;

__device__ __forceinline__ unsigned cvt_pk_bf16(float lo, float hi) { f32x2 v = {lo, hi}; bf16x2_t b = __builtin_convertvector(v, bf16x2_t); return __builtin_bit_cast(unsigned, b); }
__device__ __forceinline__ float bf_lo(unsigned w) { return __builtin_bit_cast(float, w << 16); }
__device__ __forceinline__ float bf_hi(unsigned w) { return __builtin_bit_cast(float, w & 0xffff0000u); }
__device__ __forceinline__ float fast_exp2(float x) { return __builtin_amdgcn_exp2f(x); }
__device__ __forceinline__ float fast_rcp(float x) { return __builtin_amdgcn_rcpf(x); }
__device__ __forceinline__ float sigmoidf_(float x) { return fast_rcp(1.0f + fast_exp2(-1.4426950408889634f * x)); }
__device__ __forceinline__ float wave_sum(float v) {
#pragma unroll
    for (int o = 1; o < 64; o <<= 1) v += __shfl_xor(v, o);
    return v;
}

namespace pg8 {
constexpr int BM = 256, BK = 64, HALF = 128, HTB = HALF * BK * 2, STAGE_BYTES = 8 * HTB, NXCD = 8, WGM = 8;
__host__ __device__ __forceinline__ int lds_byte(int r, int c) { const int st = (r >> 4) * 2 + (c >> 5), rr = r & 15, cc = c & 31, ob = rr * 64 + cc * 2; return st * 1024 + (ob ^ (((ob >> 9) & 1) << 5)); }
__host__ __device__ __forceinline__ void stage_rc(int b, int& R, int& C) { const int st = b / 1024, sb = b % 1024, swz = sb ^ (((sb >> 9) & 1) << 5); R = (st >> 1) * 16 + swz / 64; C = (st & 1) * 32 + (swz % 64) / 2; }
__host__ __device__ __forceinline__ int perm32(int rho) { const int n = rho >> 4, i = rho & 15; return 8 * (i >> 2) + 4 * n + (i & 3); }

typedef int i32x8 __attribute__((ext_vector_type(8)));
typedef int i32x4 __attribute__((ext_vector_type(4)));
__device__ __forceinline__ i32x8 ld32(const LAS unsigned char* p) { const i32x4 lo = *(const LAS i32x4*)p, hi = *(const LAS i32x4*)(p + 16); return __builtin_shufflevector(lo, hi, 0, 1, 2, 3, 4, 5, 6, 7); }
struct Unit { int pm, pn, e; };
struct Gemm { int lda, ldb, K; };

template <bool F8> struct DenseOrderT {
    static constexpr bool GATHER = false, FP8 = F8;
    int nM, nN, nwg, G, c;
    const char* A; const char* B; size_t a_tile, b_tile; int a_sh; size_t a_mul;
    __device__ void init(const void* A_, const void* B_, int M, int N, int lda, int ldb, int G_, int c_) {
        nM = M / BM; nN = N / BM; nwg = nM * nN; G = G_; c = c_; A = (const char*)A_; B = (const char*)B_;
        a_tile = (size_t)BM * lda * 2; b_tile = (size_t)BM * ldb * 2; a_sh = 0; a_mul = 0; }
    __device__ bool next(int i, Unit& u) const {
        const long L = (long)i * G + c; if (L >= nwg) return false;
        int wgid = (int)L; { const int q = nwg / NXCD, r = nwg % NXCD, xcd = wgid % NXCD, off = wgid / NXCD; wgid = (xcd < r ? xcd * (q + 1) : r * (q + 1) + (xcd - r) * q) + off; }
        const int nig = WGM * nN, gid = wgid / nig, fm = gid * WGM, gsz = (nM - fm) < WGM ? (nM - fm) : WGM;
        u.pm = fm + ((wgid % nig) % gsz); u.pn = (wgid % nig) / gsz; u.e = 0; return true;
    }
    __device__ __forceinline__ const char* pa(const Unit& u) const { return A + (size_t)u.pm * a_tile + (size_t)(u.pn >> a_sh) * a_mul; }
    __device__ __forceinline__ const char* pb(const Unit& u) const { return B + (size_t)u.pn * b_tile; }
    __device__ __forceinline__ unsigned arow(const Unit&, int) const { return 0u; }
};
using DenseOrder = DenseOrderT<false>; using DenseOrder8 = DenseOrderT<true>;

template <class Epi, class Sched, bool ALIGN_EPI, bool SP2>
__device__ __forceinline__ void gemm_phase(LAS unsigned char* lds, const Gemm g, const Sched& S, const Epi& E) {
    const int tid = threadIdx.x, wid = __builtin_amdgcn_readfirstlane(tid >> 6), lane = tid & 63, wr = wid >> 2, wc = wid & 3, fr = lane & 15, fq = lane >> 4;
    int K = g.K; asm volatile("" : "+s"(K));
    const int nt = K / BK;
    constexpr bool GATHER = Sched::GATHER; constexpr bool FP8 = Sched::FP8;
    unsigned cvA0[2], cvA1[2], nvA0[2], nvA1[2], voffB[2]; int Rr[2], Cc[2];
    const unsigned hstepA = (unsigned)HALF * g.lda * 2u; const size_t hstepB = (size_t)HALF * g.ldb * 2;
#pragma unroll
    for (int i = 0; i < 2; ++i) { int R, C; stage_rc(tid * 16 + i * 8192, R, C); const int Rb = Epi::PERM ? ((R & ~31) + perm32(R & 31)) : R;
        Rr[i] = R; Cc[i] = C; cvA0[i] = (unsigned)(R * g.lda + C) * 2u; cvA1[i] = cvA0[i] + hstepA; nvA0[i] = cvA0[i]; nvA1[i] = cvA1[i]; voffB[i] = (unsigned)(Rb * g.ldb + C) * 2u; }
    const size_t kstep = (size_t)(BK * 2);
    const unsigned ldsw = (unsigned)wid * 1024u;
    const int aoff = lds_byte(wr * 64 + fr, FP8 ? fq * 16 : fq * 8), boff = lds_byte(wc * 32 + fr, FP8 ? fq * 16 : fq * 8);
#define PG8_SA(b, h) (((b) * 2 + (h)) * HTB)
#define PG8_SB(b, h) ((4 + (b) * 2 + (h)) * HTB)
#define PG8_STAGE(bufoff, gbase, voff) do { _Pragma("unroll") for (int _i = 0; _i < 2; ++_i) \
        __builtin_amdgcn_global_load_lds((const unsigned*)((const char*)(gbase) + (voff)[_i]), (LAS unsigned*)(lds + (bufoff) + ldsw + _i * 8192), 16, 0, 0); } while (0)
#define PG8_STAGE_A(bufoff, gbase, half, v0, v1) do { if constexpr (GATHER) { if (half) PG8_STAGE(bufoff, gbase, v1); else PG8_STAGE(bufoff, gbase, v0); } else { PG8_STAGE(bufoff, (gbase) + ((half) ? (size_t)hstepA : (size_t)0), cvA0); } } while (0)
#define PG8_LDA(dst, b, h) do { _Pragma("unroll") for (int m = 0; m < 4; ++m) { if constexpr (FP8) dst[m][0] = ld32(lds + PG8_SA(b, h) + aoff + m * 2048); \
        else { _Pragma("unroll") for (int k = 0; k < 2; ++k) dst[m][k] = *(const LAS FragT*)(lds + PG8_SA(b, h) + aoff + m * 2048 + k * 1024); } } } while (0)
#define PG8_LDB(dst, b, h) do { _Pragma("unroll") for (int n = 0; n < 2; ++n) { if constexpr (FP8) dst[n][0] = ld32(lds + PG8_SB(b, h) + boff + n * 2048); \
        else { _Pragma("unroll") for (int k = 0; k < 2; ++k) dst[n][k] = *(const LAS FragT*)(lds + PG8_SB(b, h) + boff + n * 2048 + k * 1024); } } } while (0)
#define PG8_MMA(ai, bj, At, Bt) do { __builtin_amdgcn_s_setprio(1); _Pragma("unroll") for (int m = 0; m < 4; ++m) _Pragma("unroll") for (int n = 0; n < 2; ++n) { \
        if constexpr (FP8) asm volatile("v_mfma_scale_f32_16x16x128_f8f6f4 %0, %1, %2, %0, %3, %3 op_sel_hi:[0,0,0]" : "+v"(acc[ai][bj][m][n]) : "v"(Bt[n][0]), "v"(At[m][0]), "v"(one_scale)); \
        else { _Pragma("unroll") for (int k = 0; k < 2; ++k) acc[ai][bj][m][n] = __builtin_amdgcn_mfma_f32_16x16x32_bf16(Bt[n][k], At[m][k], acc[ai][bj][m][n], 0, 0, 0); } } \
        __builtin_amdgcn_s_setprio(0); } while (0)
#define PG8_WAIT_V(n) asm volatile("s_waitcnt vmcnt(" #n ")" ::: "memory")
#define PG8_WAIT_L(n) asm volatile("s_waitcnt lgkmcnt(" #n ")" ::: "memory")
#define PG8_BAR __builtin_amdgcn_s_barrier()
#define PG8_SCHED __builtin_amdgcn_sched_barrier(0)
    Unit cur, nxt; int ui = 0;
    if (!S.next(0, cur)) return;
    f32x4 acc[2][2][4][2];
#pragma unroll
    for (int a = 0; a < 2; ++a)
#pragma unroll
        for (int b = 0; b < 2; ++b)
#pragma unroll
            for (int m = 0; m < 4; ++m)
#pragma unroll
                for (int n = 0; n < 2; ++n) acc[a][b][m][n] = (f32x4){0.f, 0.f, 0.f, 0.f};
    using FragT = typename std::conditional<FP8, i32x8, bf16x8>::type; constexpr int NK = FP8 ? 1 : 2;
    FragT At[4][NK], B0[2][NK], B1[2][NK]; const int one_scale = 0x7F7F7F7F;
    const char* cA = S.pa(cur); const char* cB = S.pb(cur);
    if constexpr (GATHER) {
#pragma unroll
        for (int i = 0; i < 2; ++i) { cvA0[i] = S.arow(cur, Rr[i]) * (unsigned)(g.lda * 2) + (unsigned)Cc[i] * 2u; cvA1[i] = S.arow(cur, HALF + Rr[i]) * (unsigned)(g.lda * 2) + (unsigned)Cc[i] * 2u; }
    }
    static_assert(SP2, "only the SP2 loop is carried here");
    PG8_STAGE(PG8_SB(0, 0), cB, voffB); PG8_STAGE(PG8_SB(0, 1), cB + hstepB, voffB); PG8_STAGE_A(PG8_SA(0, 0), cA, 0, cvA0, cvA1); PG8_STAGE_A(PG8_SA(0, 1), cA, 1, cvA0, cvA1);
    if (wr == 1) PG8_BAR;
    PG8_WAIT_V(2); PG8_BAR;
    PG8_STAGE(PG8_SB(1, 0), cB + kstep, voffB); PG8_STAGE_A(PG8_SA(1, 0), cA + kstep, 0, cvA0, cvA1); PG8_STAGE(PG8_SB(1, 1), cB + hstepB + kstep, voffB);
    PG8_WAIT_V(6); PG8_BAR;
    for (;;) {
        const bool has_next = S.next(ui + 1, nxt);
        const char* nA = has_next ? S.pa(nxt) : cA; const char* nB = has_next ? S.pb(nxt) : cB;
        for (int t = 0; t < nt; t += 2) {
            const bool last = (t == nt - 2);
            const char* a1 = cA + (size_t)(t + 1) * kstep;
            const char* a2 = last ? nA : cA + (size_t)(t + 2) * kstep; const char* b2 = last ? nB : cB + (size_t)(t + 2) * kstep;
            const char* a3 = a2 + kstep; const char* b3 = b2 + kstep;
            unsigned xv0[2], xv1[2];
            if constexpr (GATHER) {
                if (last && has_next) {
#pragma unroll
                    for (int i = 0; i < 2; ++i) { nvA0[i] = S.arow(nxt, Rr[i]) * (unsigned)(g.lda * 2) + (unsigned)Cc[i] * 2u; nvA1[i] = S.arow(nxt, HALF + Rr[i]) * (unsigned)(g.lda * 2) + (unsigned)Cc[i] * 2u; }
                }
#pragma unroll
                for (int i = 0; i < 2; ++i) { xv0[i] = (last && has_next) ? nvA0[i] : cvA0[i]; xv1[i] = (last && has_next) ? nvA1[i] : cvA1[i]; }
            } else { xv0[0] = xv0[1] = xv1[0] = xv1[1] = 0u; }
            PG8_LDB(B0, 0, 0); PG8_LDB(B1, 0, 1); PG8_SCHED; PG8_LDA(At, 0, 0); PG8_STAGE_A(PG8_SA(1, 1), a1, 1, cvA0, cvA1);
            PG8_WAIT_V(8); PG8_WAIT_L(0); PG8_BAR; PG8_MMA(0, 0, At, B0); PG8_MMA(0, 1, At, B1); PG8_BAR; PG8_SCHED;
            PG8_LDA(At, 0, 1); PG8_STAGE(PG8_SB(0, 0), b2, voffB); PG8_STAGE(PG8_SB(0, 1), b2 + hstepB, voffB); PG8_STAGE_A(PG8_SA(0, 0), a2, 0, xv0, xv1);
            PG8_WAIT_V(8); PG8_WAIT_L(0); PG8_BAR; PG8_MMA(1, 0, At, B0); PG8_MMA(1, 1, At, B1); PG8_BAR; PG8_SCHED;
            PG8_LDB(B0, 1, 0); PG8_LDB(B1, 1, 1); PG8_SCHED; PG8_LDA(At, 1, 0); PG8_STAGE_A(PG8_SA(0, 1), a2, 1, xv0, xv1);
            PG8_WAIT_V(8); PG8_WAIT_L(0); PG8_BAR; PG8_MMA(0, 0, At, B0); PG8_MMA(0, 1, At, B1); PG8_BAR; PG8_SCHED;
            PG8_LDA(At, 1, 1); PG8_STAGE(PG8_SB(1, 0), b3, voffB); PG8_STAGE(PG8_SB(1, 1), b3 + hstepB, voffB); PG8_STAGE_A(PG8_SA(1, 0), a3, 0, xv0, xv1);
            PG8_WAIT_V(8); PG8_WAIT_L(0); PG8_BAR; PG8_MMA(1, 0, At, B0); PG8_MMA(1, 1, At, B1); PG8_BAR; PG8_SCHED;
        }
        if constexpr (ALIGN_EPI) { if (wr == 0) PG8_BAR; }
        E(acc, cur, wr, wc, fr, fq);
        if (!has_next) break;
#pragma unroll
        for (int a = 0; a < 2; ++a)
#pragma unroll
            for (int b = 0; b < 2; ++b)
#pragma unroll
                for (int m = 0; m < 4; ++m)
#pragma unroll
                    for (int n = 0; n < 2; ++n) acc[a][b][m][n] = (f32x4){0.f, 0.f, 0.f, 0.f};
        cur = nxt; cA = nA; cB = nB; ++ui;
        if constexpr (GATHER) {
#pragma unroll
            for (int i = 0; i < 2; ++i) { cvA0[i] = nvA0[i]; cvA1[i] = nvA1[i]; }
        }
        if constexpr (ALIGN_EPI) { if (wr == 1) PG8_BAR; }
    }
    PG8_WAIT_V(0);
    if constexpr (!ALIGN_EPI) { if (wr == 0) PG8_BAR; }
    PG8_BAR;
#undef PG8_SA
#undef PG8_SB
#undef PG8_STAGE
#undef PG8_STAGE_A
#undef PG8_LDA
#undef PG8_LDB
#undef PG8_MMA
#undef PG8_WAIT_V
#undef PG8_WAIT_L
#undef PG8_BAR
#undef PG8_SCHED
}
}

#define XB_TMO      128
#define XB_XCNT(j)  (256  + 64 * (j))
#define XB_XSUB(j)  (1280 + 64 * (j))
#define XB_XGEN(j)  (2304 + 64 * (j))
#define XB_TOP      3328
#define XB_TOPGEN   3392
#define XCD_BAR_WORDS 3456
#define XB_SPIN_CAP (1u << 18)

__device__ __forceinline__ unsigned xb_ld(unsigned* p)              { return __hip_atomic_load(p, __ATOMIC_RELAXED, __HIP_MEMORY_SCOPE_AGENT); }
__device__ __forceinline__ unsigned xb_add(unsigned* p, unsigned v) { return __hip_atomic_fetch_add(p, v, __ATOMIC_RELAXED, __HIP_MEMORY_SCOPE_AGENT); }
__device__ __forceinline__ unsigned xb_xcc_id() { return (unsigned)__builtin_amdgcn_s_getreg((3 << 11) | 20) & 0xFu; }
#define XB_SPIN(cond, bar) do { unsigned _sp = 0; while (cond) { __builtin_amdgcn_s_sleep(1); \
    if ((++_sp & 255u) == 0u) { if (xb_ld(&(bar)[XB_TMO])) break; if (_sp > XB_SPIN_CAP) { atomicAdd(&(bar)[XB_TMO], 1u); break; } } } } while (0)

struct XcdBarrier { unsigned* bar; unsigned x; volatile LAS unsigned* st; };

__device__ __forceinline__ XcdBarrier xcd_barrier_post(unsigned* bar, volatile LAS unsigned* st) {
    XcdBarrier b; b.bar = bar; b.x = xb_xcc_id(); b.st = st;
    if (threadIdx.x == 0) (void)xb_add(&bar[XB_XCNT(b.x)], 1u);
    return b;
}
__device__ __forceinline__ void xcd_barrier_complete(unsigned* bar, unsigned x, unsigned& nloc, unsigned& nx) {
    const unsigned G = gridDim.x * gridDim.y * gridDim.z;
    unsigned sum, cnt, mine, sp = 0u;
    for (;;) {
        sum = 0u; cnt = 0u; mine = 0u;
#pragma unroll
        for (unsigned j = 0; j < 16; ++j) { const unsigned c = xb_ld(&bar[XB_XCNT(j)]); sum += c; cnt += (c > 0u) ? 1u : 0u; mine = (j == x) ? c : mine; }
        if (sum == G) break;
        __builtin_amdgcn_s_sleep(1);
        if ((++sp & 255u) == 0u) { if (xb_ld(&bar[XB_TMO])) break; if (sp > XB_SPIN_CAP) { atomicAdd(&bar[XB_TMO], 1u); break; } }
    }
    nloc = mine > 0u ? mine : 1u; nx = cnt > 0u ? cnt : 1u;
}
__device__ __forceinline__ void xcd_barrier(const XcdBarrier& b) {
    asm volatile("s_waitcnt vmcnt(0)" ::: "memory");
    __syncthreads();
    if (threadIdx.x == 0) {
        unsigned* bar = b.bar;
        __builtin_amdgcn_s_waitcnt(0);
        unsigned nloc = b.st[0], nx = b.st[1];
        if (nloc == 0u) { xcd_barrier_complete(bar, b.x, nloc, nx); b.st[0] = nloc; b.st[1] = nx; }
        const unsigned old = xb_add(&bar[XB_XSUB(b.x)], 1u);
        const unsigned gen = old / nloc;
        if (old + 1u == (gen + 1u) * nloc) {
            __builtin_amdgcn_fence(__ATOMIC_RELEASE, "agent");
            asm volatile("s_waitcnt vmcnt(0)" ::: "memory");
            const unsigned og = xb_add(&bar[XB_TOP], 1u);
            const unsigned tg = og / nx;
            if (og + 1u == (tg + 1u) * nx) xb_add(&bar[XB_TOPGEN], 1u);
            else XB_SPIN(xb_ld(&bar[XB_TOPGEN]) == tg, bar);
            __builtin_amdgcn_fence(__ATOMIC_ACQUIRE, "agent");
            xb_add(&bar[XB_XGEN(b.x)], 1u);
            asm volatile("s_waitcnt vmcnt(0)" ::: "memory");
        } else {
            XB_SPIN(xb_ld(&bar[XB_XGEN(b.x)]) == gen, bar);
            __builtin_amdgcn_fence(__ATOMIC_ACQUIRE, "agent");
            asm volatile("s_waitcnt vmcnt(0)" ::: "memory");
        }
    }
    __syncthreads();
}

constexpr int NB = 4, SEQ = 8192, DM = 1024, NTOK = NB * SEQ, WIN = 8272, NEXP = 64, DEXP = 256, TOPK = 8;
constexpr int C_UGATE = 1024, C_Q = 2048, C_V = 4096, C_QI = 5120, C_GLR = 6224;
constexpr int NWAVES = 8, NTHR = 512;
constexpr float EPSN = 1e-6f, LOG2E = 1.4426950408889634f;
constexpr float QSCALE = 0.08838834764831845f * 1.4426950408889634f;
constexpr size_t MiB = 1u << 20;
constexpr size_t WS_CTL = 0, CTL_ZERO_BYTES = 1 * MiB;
constexpr int CW_BAR = 4096, CW_MOD = 16384, CW_CNT = 65536, CW_CUR = 65536 + 64, CW_NT = 65536 + 128;
constexpr size_t WS_TOKSEL = 1 * MiB, WS_TOKW = 2 * MiB, WS_LISTTOK = 3 * MiB, WS_LISTW = 4 * MiB + MiB / 2, WS_TILEE = 6 * MiB, WS_CHA = 8 * MiB, WS_CHH = 10 * MiB, WS_SPL = 12 * MiB, WS_LISTP = 13 * MiB;
constexpr size_t WS_WIN_T = 17 * MiB, WS_WG_T = 34 * MiB, WS_WBRR_T = 35 * MiB, WS_WBRA_T = 37 * MiB, WS_WOUT_T = 39 * MiB, WS_WRT_T = 41 * MiB, WS_WSHGU_T = 42 * MiB, WS_WSHD_T = 43 * MiB, WS_WQKV8 = 44 * MiB, WS_WGL8 = WS_WIN_T + (size_t)C_Q * 2048, WS_WBRA8 = WS_WGL8 + 2 * MiB;
constexpr size_t S0 = 48 * MiB, S1 = 112 * MiB, S2 = 176 * MiB, S3 = 240 * MiB, S4 = 304 * MiB, S5 = 368 * MiB, S6 = 432 * MiB, SX = 496 * MiB, WS_NEED = 504 * MiB;
constexpr size_t WS_H = S0, WS_URNN = S1, WS_GGATE = S2, WS_XC = S3, WS_LOGA = S4, WS_BB = S5, WS_YRNN = S1;
constexpr size_t WS_QI = S3, WS_KI = SX, WS_WI = SX + 4 * MiB, WS_SCR = S4, WS_MASK = S6;
constexpr size_t OUT_VT = 0, OUT_K = 32 * MiB;
constexpr size_t WS_Q = S2, WS_YATT = S5, WS_H8 = S6 + 32 * MiB, WS_M18 = S5 + 32 * MiB, WS_WOUT8 = WS_WBRA_T;
constexpr size_t WS_GLR = S3, WS_GLA = S4, WS_M1 = S2, WS_Y1 = S0;
constexpr size_t WS_H2 = S2, WS_WEGU = S3, WS_WED = S4, WS_ACTSH = S4 + 16 * MiB, WS_LOGITS = S4 + 48 * MiB, WS_ACT = S5, WS_Y2 = S4 + 32 * MiB, WS_X1B = S0,     WS_SLOT = S2, WS_WEGU8 = S3, WS_H2F8 = S3 + 32 * MiB, WS_WED8 = S4, WS_ACT8 = S5, WS_SLOTB2 = S5 + 68 * MiB;
__device__ __forceinline__ unsigned char* slot_row(unsigned char* ws, int pair) { return (pair < 131072 ? ws + S2 + (size_t)pair * 1024 : (pair < 196608 ? ws + S1 + (size_t)(pair - 131072) * 1024 : ws + WS_SLOTB2 + (size_t)(pair - 196608) * 1024)); }
constexpr int LDS_BYTES = 147456, LDSCTL_OFF = 145408;

using pg8::Unit;
#define EPI_ROWS for (int ai = 0; ai < 2; ++ai) _Pragma("unroll") for (int m = 0; m < 4; ++m)
__device__ __forceinline__ u32x4 pack8(const f32x4 a, const f32x4 b) { u32x4 w; w.x = cvt_pk_bf16(a[0], a[1]); w.y = cvt_pk_bf16(a[2], a[3]); w.z = cvt_pk_bf16(b[0], b[1]); w.w = cvt_pk_bf16(b[2], b[3]); return w; }
__device__ __forceinline__ void unpack8(const u32x4 w, f32x4& a, f32x4& b) { a[0] = bf_lo(w.x); a[1] = bf_hi(w.x); a[2] = bf_lo(w.y); a[3] = bf_hi(w.y); b[0] = bf_lo(w.z); b[1] = bf_hi(w.z); b[2] = bf_lo(w.w); b[3] = bf_hi(w.w); }
__device__ __forceinline__ float clamp_e4m3(float x) { return __builtin_fminf(__builtin_fmaxf(x, -448.0f), 448.0f); }
__device__ __forceinline__ u32x4 wide8(const u32x2 wa, const u32x2 wb, const bool odd) {
    const u32x2 snd = odd ? wa : wb, own = odd ? wb : wa; u32x2 rcv; rcv.x = (unsigned)__shfl_xor((int)snd.x, 16); rcv.y = (unsigned)__shfl_xor((int)snd.y, 16);
    return odd ? (u32x4){rcv.x, rcv.y, own.x, own.y} : (u32x4){own.x, own.y, rcv.x, rcv.y}; }
__device__ __forceinline__ float gelu_tanh(float x) { const float u = 0.7978845608028654f * (x + 0.044715f * x * x * x); return x * fast_rcp(1.0f + fast_exp2(-2.0f * LOG2E * u)); }

template <int MODE0, int MODE1> struct EpiSplitBf16 {
    static constexpr bool PERM = true;
    bf16* O0; bf16* O1; int ldc; int split; float s0, s1;
    __device__ __forceinline__ void operator()(const f32x4 (&acc)[2][2][4][2], const Unit& u, int wr, int wc, int fr, int fq) const {
        int colt = u.pn * 256; const bool second = colt >= split; bf16* base = second ? O1 : O0; if (second) colt -= split; const float sc = second ? s1 : s0;
        const int row0 = u.pm * 256 + wr * 64 + fr, col0 = colt + wc * 32 + 8 * fq;
#pragma unroll
        EPI_ROWS { bf16* rowp = base + (size_t)(row0 + ai * 128 + m * 16) * ldc + col0;
#pragma unroll
            for (int bj = 0; bj < 2; ++bj) { f32x4 v0 = acc[ai][bj][m][0], v1 = acc[ai][bj][m][1];
                const int mode = second ? MODE1 : MODE0;
                if (mode == 0) { v0 = v0 * sc; v1 = v1 * sc; }
                else if (mode == 1) {
#pragma unroll
                    for (int j = 0; j < 4; ++j) { v0[j] = gelu_tanh(v0[j]); v1[j] = gelu_tanh(v1[j]); } }
                else {
#pragma unroll
                    for (int j = 0; j < 4; ++j) { v0[j] = sigmoidf_(v0[j] * sc); v1[j] = sigmoidf_(v1[j] * sc); } }
                *(u32x4*)(rowp + bj * 128) = pack8(v0, v1); } }
    }
};
struct EpiSplitF8 {
    static constexpr bool PERM = true;
    unsigned char* O0; unsigned char* O1; int ldc; int split; float s0, s1;
    __device__ __forceinline__ void operator()(const f32x4 (&acc)[2][2][4][2], const Unit& u, int wr, int wc, int fr, int fq) const {
        int colt = u.pn * 256; const bool second = colt >= split; unsigned char* base = second ? O1 : O0; if (second) colt -= split; const float sc = second ? s1 : s0;
        const int row0 = u.pm * 256 + wr * 64 + fr, col0 = colt + wc * 32 + 8 * fq;
#pragma unroll
        EPI_ROWS { unsigned char* rowp = base + (size_t)(row0 + ai * 128 + m * 16) * ldc + col0;
#pragma unroll
            for (int bj = 0; bj < 2; ++bj) { f32x4 a = acc[ai][bj][m][0] * sc, b = acc[ai][bj][m][1] * sc;
#pragma unroll
                for (int j = 0; j < 4; ++j) { a[j] = clamp_e4m3(a[j]); b[j] = clamp_e4m3(b[j]); }
                int w0 = __builtin_amdgcn_cvt_pk_fp8_f32(a[0], a[1], 0, false); w0 = __builtin_amdgcn_cvt_pk_fp8_f32(a[2], a[3], w0, true);
                int w1 = __builtin_amdgcn_cvt_pk_fp8_f32(b[0], b[1], 0, false); w1 = __builtin_amdgcn_cvt_pk_fp8_f32(b[2], b[3], w1, true);
                *(u32x2*)(rowp + bj * 128) = (u32x2){(unsigned)w0, (unsigned)w1}; } }
    }
};
struct EpiF8W {
    static constexpr bool PERM = true;
    unsigned char* O; int ldc; float sc;
    __device__ __forceinline__ void operator()(const f32x4 (&acc)[2][2][4][2], const Unit& u, int wr, int wc, int fr, int fq) const {
        const int row0 = u.pm * 256 + wr * 64 + fr, col0 = u.pn * 256 + wc * 32 + 8 * (fq & ~1); const bool odd = fq & 1;
#pragma unroll
        for (int ai = 0; ai < 2; ++ai)
#pragma unroll
            for (int mp = 0; mp < 4; mp += 2) { unsigned char* rowp = O + (size_t)(row0 + ai * 128 + (mp + (odd ? 1 : 0)) * 16) * ldc + col0;
#pragma unroll
                for (int bj = 0; bj < 2; ++bj) { u32x2 W[2];
#pragma unroll
                    for (int mi = 0; mi < 2; ++mi) { f32x4 a = acc[ai][bj][mp + mi][0] * sc, b = acc[ai][bj][mp + mi][1] * sc;
#pragma unroll
                        for (int j = 0; j < 4; ++j) { a[j] = clamp_e4m3(a[j]); b[j] = clamp_e4m3(b[j]); }
                        int w0 = __builtin_amdgcn_cvt_pk_fp8_f32(a[0], a[1], 0, false); w0 = __builtin_amdgcn_cvt_pk_fp8_f32(a[2], a[3], w0, true);
                        int w1 = __builtin_amdgcn_cvt_pk_fp8_f32(b[0], b[1], 0, false); w1 = __builtin_amdgcn_cvt_pk_fp8_f32(b[2], b[3], w1, true);
                        W[mi] = (u32x2){(unsigned)w0, (unsigned)w1}; }
                    *(u32x4*)(rowp + bj * 128) = wide8(W[0], W[1], odd); } }
    }
};
struct EpiIdx {
    static constexpr bool PERM = true;
    bf16* QI; bf16* KI; float* WI;
    __device__ __forceinline__ void operator()(const f32x4 (&acc)[2][2][4][2], const Unit& u, int wr, int wc, int fr, int fq) const {
        const int row0 = u.pm * 256 + wr * 64 + fr;
        if (u.pn < 4) { const int col0 = u.pn * 256 + wc * 32 + 8 * fq;
#pragma unroll
            EPI_ROWS { bf16* rowp = QI + (size_t)(row0 + ai * 128 + m * 16) * 1024 + col0;
#pragma unroll
                for (int bj = 0; bj < 2; ++bj) *(u32x4*)(rowp + bj * 128) = pack8(acc[ai][bj][m][0] * 0.125f, acc[ai][bj][m][1] * 0.125f); }
        } else { const int col0 = wc * 32 + 8 * fq;
#pragma unroll
            EPI_ROWS { const size_t row = (size_t)(row0 + ai * 128 + m * 16);
                if (col0 < 64) *(u32x4*)(KI + row * 64 + col0) = pack8(acc[ai][0][m][0], acc[ai][0][m][1]);
                else if (col0 < 80) { *(f32x4*)(WI + row * 16 + (col0 - 64)) = acc[ai][0][m][0] * 0.125f; *(f32x4*)(WI + row * 16 + (col0 - 64) + 4) = acc[ai][0][m][1] * 0.125f; } }
        }
    }
};
struct EpiBf16 {
    static constexpr bool PERM = true;
    bf16* O; int ldc;
    __device__ __forceinline__ void operator()(const f32x4 (&acc)[2][2][4][2], const Unit& u, int wr, int wc, int fr, int fq) const {
        const int row0 = u.pm * 256 + wr * 64 + fr, col0 = u.pn * 256 + wc * 32 + 8 * fq;
#pragma unroll
        EPI_ROWS { bf16* rowp = O + (size_t)(row0 + ai * 128 + m * 16) * ldc + col0;
#pragma unroll
            for (int bj = 0; bj < 2; ++bj) *(u32x4*)(rowp + bj * 128) = pack8(acc[ai][bj][m][0], acc[ai][bj][m][1]); }
    }
};
template <int MODE> struct EpiMerge {
    static constexpr bool PERM = true;
    bf16* O; const bf16* Gt; unsigned char* O8; float isc, unused_;
    __device__ __forceinline__ void operator()(const f32x4 (&acc)[2][2][4][2], const Unit& u, int wr, int wc, int fr, int fq) const {
        const int row0 = u.pm * 256 + wr * 64 + fr, col0 = u.pn * 256 + wc * 32 + 8 * fq;
#pragma unroll
        EPI_ROWS { const size_t off = (size_t)(row0 + ai * 128 + m * 16) * 1024 + col0;
#pragma unroll
            for (int bj = 0; bj < 2; ++bj) { f32x4 g0, g1; unpack8(*(const u32x4*)(Gt + off + bj * 128), g0, g1);
                f32x4 v0 = g0 * (acc[ai][bj][m][0] * isc), v1 = g1 * (acc[ai][bj][m][1] * isc);
                if (MODE >= 1) { f32x4 o0, o1; unpack8(*(const u32x4*)(O + off + bj * 128), o0, o1); v0 = v0 + o0; v1 = v1 + o1; }
                if (MODE == 2) {
#pragma unroll
                    for (int j = 0; j < 4; ++j) { v0[j] = clamp_e4m3(v0[j]); v1[j] = clamp_e4m3(v1[j]); }
                    int w0 = __builtin_amdgcn_cvt_pk_fp8_f32(v0[0], v0[1], 0, false); w0 = __builtin_amdgcn_cvt_pk_fp8_f32(v0[2], v0[3], w0, true);
                    int w1 = __builtin_amdgcn_cvt_pk_fp8_f32(v1[0], v1[1], 0, false); w1 = __builtin_amdgcn_cvt_pk_fp8_f32(v1[2], v1[3], w1, true);
                    *(u32x2*)(O8 + off + bj * 128) = (u32x2){(unsigned)w0, (unsigned)w1}; }
                else *(u32x4*)(O + off + bj * 128) = pack8(v0, v1); } }
    }
};
struct EpiF32 {
    static constexpr bool PERM = false;
    float* C; int ldc; int ncols;
    __device__ __forceinline__ void operator()(const f32x4 (&acc)[2][2][4][2], const Unit& u, int wr, int wc, int fr, int fq) const {
        const int row0 = u.pm * 256 + wr * 64 + fr, col0 = u.pn * 256 + wc * 32 + 4 * fq;
#pragma unroll
        EPI_ROWS { float* rowp = C + (size_t)(row0 + ai * 128 + m * 16) * ldc + col0;
#pragma unroll
            for (int bj = 0; bj < 2; ++bj)
#pragma unroll
                for (int n = 0; n < 2; ++n) if (col0 + bj * 128 + n * 16 < ncols) *(f32x4*)(rowp + bj * 128 + n * 16) = acc[ai][bj][m][n]; }
    }
};
struct EpiGate {
    static constexpr bool PERM = true;
    const bf16* XC; bf16* LOGA; bf16* BB; const float* b_a; const float* b_x; const float* lam;
    __device__ __forceinline__ void operator()(const f32x4 (&acc)[2][2][4][2], const Unit& u, int wr, int wc, int fr, int fq) const {
        const int row0 = u.pm * 256 + wr * 64 + fr, ch0 = u.pn * 128 + wc * 32 + 8 * fq;
        f32x4 ba[2], bx[2], sp[2];
#pragma unroll
        for (int n = 0; n < 2; ++n) { ba[n] = *(const f32x4*)(b_a + ch0 + 4 * n); bx[n] = *(const f32x4*)(b_x + ch0 + 4 * n); sp[n] = *(const f32x4*)(lam + ch0 + 4 * n); }
#pragma unroll
        EPI_ROWS { const size_t off = (size_t)(row0 + ai * 128 + m * 16) * 1024 + ch0;
            f32x4 x0, x1; unpack8(*(const u32x4*)(XC + off), x0, x1);
            f32x4 la[2], bv[2];
#pragma unroll
            for (int n = 0; n < 2; ++n) { const f32x4 xv = n ? x1 : x0;
#pragma unroll
                for (int j = 0; j < 4; ++j) {
                    const float r = sigmoidf_(acc[ai][0][m][n][j] + ba[n][j]), ig = sigmoidf_(acc[ai][1][m][n][j] + bx[n][j]);
                    la[n][j] = r * sp[n][j]; bv[n][j] = ig * xv[j]; } }
            *(u32x4*)(LOGA + off) = pack8(la[0], la[1]); *(u32x4*)(BB + off) = pack8(bv[0], bv[1]); asm volatile("" ::: "memory"); }
    }
};
struct EpiGlu {
    static constexpr bool PERM = true;
    bf16* ACT; float isc;
    __device__ __forceinline__ void operator()(const f32x4 (&acc)[2][2][4][2], const Unit& u, int wr, int wc, int fr, int fq) const {
        const int row0 = u.pm * 256 + wr * 64 + fr, col0 = u.pn * 128 + wc * 32 + 8 * fq;
#pragma unroll
        EPI_ROWS { f32x4 v0, v1;
#pragma unroll
            for (int j = 0; j < 4; ++j) { const float g0 = acc[ai][0][m][0][j] * isc, g1 = acc[ai][0][m][1][j] * isc; v0[j] = g0 * sigmoidf_(g0) * (acc[ai][1][m][0][j] * isc); v1[j] = g1 * sigmoidf_(g1) * (acc[ai][1][m][1][j] * isc); }
            *(u32x4*)(ACT + (size_t)(row0 + ai * 128 + m * 16) * 256 + col0) = pack8(v0, v1); }
    }
};
struct EpiGlu8 {
    static constexpr bool PERM = true;
    unsigned char* ACT; float isc;
    __device__ __forceinline__ void operator()(const f32x4 (&acc)[2][2][4][2], const Unit& u, int wr, int wc, int fr, int fq) const {
        const int row0 = u.pm * 256 + wr * 64 + fr, col0 = u.pn * 128 + wc * 32 + 8 * fq;
#pragma unroll
        EPI_ROWS { float v[8];
#pragma unroll
            for (int j = 0; j < 4; ++j) { const float g0 = acc[ai][0][m][0][j] * isc, g1 = acc[ai][0][m][1][j] * isc; v[j] = clamp_e4m3(g0 * sigmoidf_(g0) * (acc[ai][1][m][0][j] * isc)); v[4 + j] = clamp_e4m3(g1 * sigmoidf_(g1) * (acc[ai][1][m][1][j] * isc)); }
            int w0 = __builtin_amdgcn_cvt_pk_fp8_f32(v[0], v[1], 0, false); w0 = __builtin_amdgcn_cvt_pk_fp8_f32(v[2], v[3], w0, true);
            int w1 = __builtin_amdgcn_cvt_pk_fp8_f32(v[4], v[5], 0, false); w1 = __builtin_amdgcn_cvt_pk_fp8_f32(v[6], v[7], w1, true);
            *(u32x2*)(ACT + (size_t)(row0 + ai * 128 + m * 16) * 256 + col0) = (u32x2){(unsigned)w0, (unsigned)w1}; }
    }
};
struct EpiSlot {
    static constexpr bool PERM = true;
    unsigned char* ws; const int* list_pair; const float* list_w; float isc;
    __device__ __forceinline__ void operator()(const f32x4 (&acc)[2][2][4][2], const Unit& u, int wr, int wc, int fr, int fq) const {
        const int row0 = u.pm * 256 + wr * 64 + fr, col0 = u.pn * 256 + wc * 32 + 8 * (fq & ~1); const bool odd = fq & 1;
        float wl[2][4]; int pl[2][2];
#pragma unroll
        for (int ai = 0; ai < 2; ++ai) {
#pragma unroll
            for (int m = 0; m < 4; ++m) wl[ai][m] = list_w[row0 + ai * 128 + m * 16];
#pragma unroll
            for (int mp = 0; mp < 2; ++mp) pl[ai][mp] = list_pair[row0 + ai * 128 + (2 * mp + (odd ? 1 : 0)) * 16]; }
#pragma unroll
        for (int ai = 0; ai < 2; ++ai)
#pragma unroll
            for (int mp = 0; mp < 4; mp += 2) { u32x2 W[2][2];
#pragma unroll
                for (int mi = 0; mi < 2; ++mi) { const float w = wl[ai][mp + mi] * isc;
#pragma unroll
                    for (int bj = 0; bj < 2; ++bj) { f32x4 a = acc[ai][bj][mp + mi][0] * w, b = acc[ai][bj][mp + mi][1] * w;
#pragma unroll
                        for (int j = 0; j < 4; ++j) { a[j] = clamp_e4m3(a[j]); b[j] = clamp_e4m3(b[j]); }
                        int w0 = __builtin_amdgcn_cvt_pk_fp8_f32(a[0], a[1], 0, false); w0 = __builtin_amdgcn_cvt_pk_fp8_f32(a[2], a[3], w0, true);
                        int w1 = __builtin_amdgcn_cvt_pk_fp8_f32(b[0], b[1], 0, false); w1 = __builtin_amdgcn_cvt_pk_fp8_f32(b[2], b[3], w1, true);
                        W[mi][bj] = (u32x2){(unsigned)w0, (unsigned)w1}; } }
                const int pair = pl[ai][mp >> 1];
                unsigned char* rowp = slot_row(ws, pair < 0 ? 0 : pair) + col0;
#pragma unroll
                for (int bj = 0; bj < 2; ++bj) { const u32x2 snd = odd ? W[0][bj] : W[1][bj], own = odd ? W[1][bj] : W[0][bj];
                    u32x2 rcv; rcv.x = (unsigned)__shfl_xor((int)snd.x, 16); rcv.y = (unsigned)__shfl_xor((int)snd.y, 16);
                    const u32x4 o = odd ? (u32x4){rcv.x, rcv.y, own.x, own.y} : (u32x4){own.x, own.y, rcv.x, rcv.y};
                    if (pair >= 0) *(u32x4*)(rowp + bj * 128) = o; } }
    }
};
template <bool GATH, bool F8 = false> struct MoeOrder {
    static constexpr bool GATHER = GATH, FP8 = F8;
    const int* tile_e; const int* list_tok; int nunits, ntn, pn0, G, c; const char* A; const char* B; size_t a_tile, b_e, b_tile;
    __device__ bool next(int i, Unit& u) const {
        int L;
        if ((G & 7) == 0) { const int q = nunits / 8, r = nunits % 8, xcd = c & 7, off = i * (G >> 3) + (c >> 3), len = q + (xcd < r ? 1 : 0); if (off >= len) return false; L = (xcd < r ? xcd * (q + 1) : r * (q + 1) + (xcd - r) * q) + off; }
        else { const long Ll = (long)i * G + c; if (Ll >= nunits) return false; L = (int)Ll; }
        u.pm = L / ntn; u.pn = pn0 + L % ntn; u.e = tile_e[u.pm]; return true; }
    __device__ __forceinline__ const char* pa(const Unit& u) const { return GATH ? A : A + (size_t)u.pm * a_tile; }
    __device__ __forceinline__ const char* pb(const Unit& u) const { return B + (size_t)u.e * b_e + (size_t)u.pn * b_tile; }
    __device__ __forceinline__ unsigned arow(const Unit& u, int r) const { return (unsigned)list_tok[u.pm * 256 + r]; }
};

#define LDS_WAIT() asm volatile("s_waitcnt lgkmcnt(0)" ::: "memory")
__device__ __forceinline__ unsigned lds_add(LAS unsigned* p, unsigned v) { return __hip_atomic_fetch_add(p, v, __ATOMIC_RELAXED, __HIP_MEMORY_SCOPE_WORKGROUP); }

__device__ __forceinline__ void tr_item(const float* W, int ldw, int N, bf16* WT, int ldt, int blk, int blkstride, int rowoff, LAS float* scr, int kb, int nb, int lane) {
    const int k0 = 64 * kb, n0 = 32 * nb;
    float tv[32];
#pragma unroll
    for (int i = 0; i < 32; ++i) { const int kk = 2 * i + (lane >> 5), n = n0 + (lane & 31); tv[i] = (n < N) ? W[(size_t)(k0 + kk) * ldw + n] : 0.f; }
#pragma unroll
    for (int i = 0; i < 32; ++i) { const int kk = 2 * i + (lane >> 5); scr[kk * 33 + (lane & 31)] = tv[i]; }
    LDS_WAIT(); asm volatile("" ::: "memory");
    const int c = lane & 7;
#pragma unroll
    for (int j = 0; j < 4; ++j) { const int nl = (lane >> 3) + 8 * j, n = n0 + nl; const LAS float* s = scr + (8 * c) * 33 + nl;
        u32x4 o; o.x = cvt_pk_bf16(s[0 * 33], s[1 * 33]); o.y = cvt_pk_bf16(s[2 * 33], s[3 * 33]); o.z = cvt_pk_bf16(s[4 * 33], s[5 * 33]); o.w = cvt_pk_bf16(s[6 * 33], s[7 * 33]);
        if (n < N) { const int drow = rowoff + (n / blk) * blkstride + (n % blk); *(u32x4*)(WT + (size_t)drow * ldt + k0 + 8 * c) = o; } }
    LDS_WAIT(); asm volatile("" ::: "memory");
}
__device__ __forceinline__ unsigned cvt4_fp8(float a, float b, float c, float d) { int w = __builtin_amdgcn_cvt_pk_fp8_f32(a, b, 0, false); w = __builtin_amdgcn_cvt_pk_fp8_f32(c, d, w, true); return (unsigned)w; }
__device__ __forceinline__ void tr_item_fp8(const float* W, int ldw, int N, unsigned char* WT, int ldt, int blk, int blkstride, int rowoff, float scale, LAS float* scr, int kb, int nb, int lane) {
    const int k0 = 64 * kb, n0 = 32 * nb;
    float tv[32];
#pragma unroll
    for (int i = 0; i < 32; ++i) { const int kk = 2 * i + (lane >> 5), n = n0 + (lane & 31); tv[i] = (n < N) ? W[(size_t)(k0 + kk) * ldw + n] : 0.f; }
#pragma unroll
    for (int i = 0; i < 32; ++i) { const int kk = 2 * i + (lane >> 5); scr[kk * 33 + (lane & 31)] = tv[i]; }
    LDS_WAIT(); asm volatile("" ::: "memory");
    const int c = lane & 7;
#pragma unroll
    for (int j = 0; j < 4; ++j) { const int nl = (lane >> 3) + 8 * j, n = n0 + nl; const LAS float* s = scr + (8 * c) * 33 + nl;
        u32x2 o; o.x = cvt4_fp8(s[0 * 33] * scale, s[1 * 33] * scale, s[2 * 33] * scale, s[3 * 33] * scale); o.y = cvt4_fp8(s[4 * 33] * scale, s[5 * 33] * scale, s[6 * 33] * scale, s[7 * 33] * scale);
        if (n < N) { const int drow = rowoff + (n / blk) * blkstride + (n % blk); *(u32x2*)(WT + (size_t)drow * ldt + k0 + 8 * c) = o; } }
    LDS_WAIT(); asm volatile("" ::: "memory");
}
__device__ __forceinline__ void tr_matrix(const float* W, int K, int N, int ldw, bf16* WT, int ldt, int blk, int blkstride, int rowoff, LAS float* scr, int gw, int NGW, int lane) {
    const int nbn = (N + 31) / 32, nit = (K / 64) * nbn;
    for (int it = gw; it < nit; it += NGW) tr_item(W, ldw, N, WT, ldt, blk, blkstride, rowoff, scr, it / nbn, it % nbn, lane);
}

struct In {
    const float *x, *c, *w_ada, *b_ada, *norm_gain, *w_in, *conv_w, *conv_b, *w_rg_a, *b_rg_a, *w_rg_x, *b_rg_x, *lru_lambda, *w_br_rnn, *w_br_attn, *w_out, *rel_bias,
                *w_router, *router_bias, *w_exp_gate, *w_exp_up, *w_exp_down, *w_sh_gate, *w_sh_up, *w_sh_down;
};

__device__ __forceinline__ void p0_prologue(const In& in, unsigned char* ws, LAS unsigned char* lds, int vcu, int G) {
    const int tid = threadIdx.x, lane = tid & 63, wave = __builtin_amdgcn_readfirstlane(tid >> 6);
    LAS float* scr = (LAS float*)(lds + wave * 16384);
    const int gw = vcu * NWAVES + wave, NGW = G * NWAVES;
    tr_matrix(in.w_in, 1024, C_Q, WIN, (bf16*)(ws + WS_WIN_T), 1024, 1 << 30, 0, 0, scr, gw, NGW, lane);
    tr_matrix(in.w_in + C_QI, 1024, C_GLR - C_QI, WIN, (bf16*)(ws + WS_WIN_T) + (size_t)C_QI * 1024, 1024, 1 << 30, 0, 0, scr, gw, NGW, lane);
    for (int it = gw; it < 16 * 64; it += NGW) tr_item_fp8(in.w_in + C_GLR, WIN, 2048, ws + WS_WGL8, 1024, 1 << 30, 0, 0, 32.0f, scr, it / 64, it % 64, lane);
    for (int it = gw; it < 16 * 96; it += NGW) tr_item_fp8(in.w_in + C_Q, WIN, 3072, ws + WS_WQKV8, 1024, 1 << 30, 0, 0, 32.0f, scr, it / 96, it % 96, lane);
    tr_matrix(in.w_br_rnn, 1024, 1024, 1024, (bf16*)(ws + WS_WBRR_T), 1024, 1 << 30, 0, 0, scr, gw, NGW, lane);
    for (int it = gw; it < 16 * 32; it += NGW) tr_item_fp8(in.w_br_attn, 1024, 1024, ws + WS_WBRA8, 1024, 1 << 30, 0, 0, 32.0f, scr, it / 32, it % 32, lane);
    for (int it = gw; it < 16 * 32; it += NGW) tr_item_fp8(in.w_out, 1024, 1024, ws + WS_WOUT8, 1024, 1 << 30, 0, 0, 32.0f, scr, it / 32, it % 32, lane);
    tr_matrix(in.w_router, 1024, 64, 64, (bf16*)(ws + WS_WRT_T), 1024, 1 << 30, 0, 0, scr, gw, NGW, lane);
    tr_matrix(in.w_sh_gate, 1024, 256, 256, (bf16*)(ws + WS_WSHGU_T), 1024, 128, 256, 0, scr, gw, NGW, lane);
    tr_matrix(in.w_sh_up, 1024, 256, 256, (bf16*)(ws + WS_WSHGU_T), 1024, 128, 256, 128, scr, gw, NGW, lane);
    tr_matrix(in.w_sh_down, 256, 1024, 1024, (bf16*)(ws + WS_WSHD_T), 256, 1 << 30, 0, 0, scr, gw, NGW, lane);
    float* MOD = (float*)(ws + WS_CTL) + CW_MOD; LAS float* part = (LAS float*)(lds + 16384); LAS float* sc_ = (LAS float*)lds;
    __syncthreads();
    if (vcu < 96) { for (int i = tid; i < 4096; i += NTHR) { const float cv = in.c[i]; sc_[i] = cv * sigmoidf_(cv); } }
    __syncthreads();
    for (int jb = vcu; jb < 96; jb += G) { const int j = jb * 64 + lane;
        float a0 = 0.f, a1 = 0.f, a2 = 0.f, a3 = 0.f;
#pragma unroll 16
        for (int k = wave * 128; k < wave * 128 + 128; ++k) { const float w = in.w_ada[(size_t)k * 6144 + j];
            a0 += sc_[k] * w; a1 += sc_[1024 + k] * w; a2 += sc_[2048 + k] * w; a3 += sc_[3072 + k] * w; }
        part[(wave * 4 + 0) * 64 + lane] = a0; part[(wave * 4 + 1) * 64 + lane] = a1; part[(wave * 4 + 2) * 64 + lane] = a2; part[(wave * 4 + 3) * 64 + lane] = a3;
        __syncthreads();
        if (wave < 4) { float sum = in.b_ada[j];
#pragma unroll
            for (int w2 = 0; w2 < 8; ++w2) sum += part[(w2 * 4 + wave) * 64 + lane];
            MOD[wave * 6144 + j] = sum; }
        __syncthreads(); }
    bf16* WG = (bf16*)(ws + WS_WG_T);
    for (int idx = vcu * NTHR + tid; idx < 2048 * 256; idx += G * NTHR) { const int row = idx >> 8, kk = idx & 255, pn = row >> 8, within = row & 255, type = within >> 7, e = within & 127;
        float v = 0.f; if ((kk >> 7) == (pn & 1)) v = (type ? in.w_rg_x : in.w_rg_a)[((size_t)pn * 128 + (kk & 127)) * 128 + e];
        WG[idx] = (bf16)(cvt_pk_bf16(v, 0.f) & 0xffffu); }
    { float* SPL = (float*)(ws + WS_SPL); for (int i = vcu * NTHR + tid; i < 1024; i += G * NTHR) SPL[i] = -8.0f * LOG2E * log1pf(__expf(-in.lru_lambda[i])); }
    u32x4* z = (u32x4*)(ws + WS_WRT_T + 64 * 1024 * 2);
    for (int i = vcu * NTHR + tid; i < 192 * 1024 * 2 / 16; i += G * NTHR) z[i] = (u32x4){0u, 0u, 0u, 0u};
}

__device__ __forceinline__ void p1_norm_rows(const In& in, unsigned char* ws, int vcu, int G) {
    const int tid = threadIdx.x, lane = tid & 63, wave = __builtin_amdgcn_readfirstlane(tid >> 6);
    const int gw = vcu * NWAVES + wave, NGW = G * NWAVES;
    const float* MOD = (const float*)(ws + WS_CTL) + CW_MOD; bf16* H = (bf16*)(ws + WS_H);
    for (int m0 = gw; m0 < NTOK; m0 += 2 * NGW) {
        f32x4 v[2][4]; int mr[2];
#pragma unroll
        for (int q = 0; q < 2; ++q) { mr[q] = (m0 + q * NGW < NTOK) ? m0 + q * NGW : m0; const f32x4* xr = (const f32x4*)(in.x + (size_t)mr[q] * DM) + 2 * lane;
#pragma unroll
            for (int j = 0; j < 2; ++j) { v[q][2 * j] = xr[128 * j]; v[q][2 * j + 1] = xr[128 * j + 1]; } }
#pragma unroll
        for (int q = 0; q < 2; ++q) { const int mrow = mr[q], b = mrow >> 13; float s2 = 0.f;
#pragma unroll
            for (int j = 0; j < 4; ++j) s2 += (v[q][j].x * v[q][j].x + v[q][j].y * v[q][j].y) + (v[q][j].z * v[q][j].z + v[q][j].w * v[q][j].w);
            const float rstd = 1.0f / sqrtf(wave_sum(s2) * (1.f / DM) + EPSN);
            u32x4* o16 = (u32x4*)(H + (size_t)mrow * DM) + lane; u32x2* o8 = (u32x2*)(ws + WS_H8 + (size_t)mrow * DM) + lane;
#pragma unroll
            for (int j = 0; j < 2; ++j) { f32x4 r[2];
#pragma unroll
                for (int k = 0; k < 2; ++k) { const int col = 512 * j + 8 * lane + 4 * k; const f32x4 g = *(const f32x4*)(in.norm_gain + col), sh = *(const f32x4*)(MOD + b * 6144 + col), sc = *(const f32x4*)(MOD + b * 6144 + 1024 + col);
                    r[k] = (v[q][2 * j + k] * rstd * g) * (sc + 1.0f) + sh; }
                o16[64 * j] = pack8(r[0], r[1]);
                o8[64 * j] = (u32x2){cvt4_fp8(clamp_e4m3(r[0].x), clamp_e4m3(r[0].y), clamp_e4m3(r[0].z), clamp_e4m3(r[0].w)), cvt4_fp8(clamp_e4m3(r[1].x), clamp_e4m3(r[1].y), clamp_e4m3(r[1].z), clamp_e4m3(r[1].w))}; } } }
}

__device__ __forceinline__ void p3_conv(const In& in, unsigned char* ws, int vcu, int G) {
    const int gt = vcu * NTHR + threadIdx.x, NT = G * NTHR;
    const bf16* U = (const bf16*)(ws + WS_URNN); bf16* XC = (bf16*)(ws + WS_XC);
    const bool fixed_ch = (NT % 128) == 0; const int ch0 = (gt & 127) * 8;
    float cw[4][8], cb[8];
#pragma unroll
    for (int j = 0; j < 8; ++j) { cb[j] = in.conv_b[ch0 + j];
#pragma unroll
        for (int k = 0; k < 4; ++k) cw[k][j] = in.conv_w[k * 1024 + ch0 + j]; }
    for (int it = gt; it < NTOK * 128; it += NT) { const int row = it >> 7, ch = (it & 127) * 8, t = row & (SEQ - 1);
        if (!fixed_ch) {
#pragma unroll
            for (int j = 0; j < 8; ++j) { cb[j] = in.conv_b[ch + j];
#pragma unroll
                for (int k = 0; k < 4; ++k) cw[k][j] = in.conv_w[k * 1024 + ch + j]; } }
        u32x4 uu[4];
#pragma unroll
        for (int k = 0; k < 4; ++k) uu[k] = (t - 3 + k >= 0) ? *(const u32x4*)(U + (size_t)(row - 3 + k) * 1024 + ch) : (u32x4){0u, 0u, 0u, 0u};
        float a[8];
#pragma unroll
        for (int j = 0; j < 8; ++j) a[j] = cb[j];
#pragma unroll
        for (int k = 0; k < 4; ++k) { f32x4 u0, u1; unpack8(uu[k], u0, u1);
#pragma unroll
            for (int j = 0; j < 4; ++j) { a[j] += cw[k][j] * u0[j]; a[4 + j] += cw[k][4 + j] * u1[j]; } }
        *(u32x4*)(XC + (size_t)row * 1024 + ch) = pack8((f32x4){a[0], a[1], a[2], a[3]}, (f32x4){a[4], a[5], a[6], a[7]}); }
}

constexpr int SCH = 64, NCH = SEQ / SCH;
__device__ __forceinline__ void p5_scan_local(unsigned char* ws, int vcu, int G) {
    const int gt = vcu * NTHR + threadIdx.x, NT = G * NTHR;
    const bf16* LA = (const bf16*)(ws + WS_LOGA); const bf16* BBp = (const bf16*)(ws + WS_BB); float* CHA = (float*)(ws + WS_CHA); float* CHH = (float*)(ws + WS_CHH);
    for (int it = gt; it < NB * NCH * 256; it += NT) { const int cq = it & 255, bc = it >> 8; const size_t base = (size_t)bc * SCH * 1024 + cq * 4;
        f32x4 h = {0.f, 0.f, 0.f, 0.f}, sl = {0.f, 0.f, 0.f, 0.f};
#pragma unroll 8
        for (int r = 0; r < SCH; ++r) { const u32x2 la = *(const u32x2*)(LA + base + (size_t)r * 1024), bb = *(const u32x2*)(BBp + base + (size_t)r * 1024);
            const f32x4 l = {bf_lo(la.x), bf_hi(la.x), bf_lo(la.y), bf_hi(la.y)}, bv = {bf_lo(bb.x), bf_hi(bb.x), bf_lo(bb.y), bf_hi(bb.y)};
#pragma unroll
            for (int j = 0; j < 4; ++j) { const float a = fast_exp2(l[j]); h[j] = a * h[j] + __builtin_amdgcn_sqrtf(1.0f - a * a) * bv[j]; sl[j] += l[j]; } }
        *(f32x4*)(CHA + (size_t)it * 4) = sl; *(f32x4*)(CHH + (size_t)it * 4) = h; }
}
__device__ __forceinline__ void p7_scan_final(unsigned char* ws, int vcu, int G) {
    const int gt = vcu * NTHR + threadIdx.x, NT = G * NTHR;
    const bf16* LA = (const bf16*)(ws + WS_LOGA); const bf16* BBp = (const bf16*)(ws + WS_BB); const bf16* GG = (const bf16*)(ws + WS_GGATE); bf16* Y = (bf16*)(ws + WS_YRNN);
    const float* CHA = (const float*)(ws + WS_CHA); const float* CHH = (const float*)(ws + WS_CHH);
    for (int it = gt; it < NB * NCH * 256; it += NT) { const int cq = it & 255, bc = it >> 8, ch = bc & (NCH - 1), b = bc / NCH; const size_t base = (size_t)bc * SCH * 1024 + cq * 4;
        f32x4 h = {0.f, 0.f, 0.f, 0.f};
        for (int c0 = 0; c0 < ch; c0 += 16) { f32x4 av[16], hv[16];
#pragma unroll
            for (int u = 0; u < 16; ++u) { const int c2 = (c0 + u < ch) ? c0 + u : ch - 1; const size_t o = ((size_t)(b * NCH + c2) * 256 + cq) * 4; av[u] = *(const f32x4*)(CHA + o); hv[u] = *(const f32x4*)(CHH + o); }
#pragma unroll
            for (int u = 0; u < 16; ++u) if (c0 + u < ch) {
#pragma unroll
                for (int j = 0; j < 4; ++j) h[j] = fast_exp2(av[u][j]) * h[j] + hv[u][j]; } }
#pragma unroll 8
        for (int r = 0; r < SCH; ++r) { const size_t o = base + (size_t)r * 1024; const u32x2 la = *(const u32x2*)(LA + o), bb = *(const u32x2*)(BBp + o), gg = *(const u32x2*)(GG + o);
            const f32x4 l = {bf_lo(la.x), bf_hi(la.x), bf_lo(la.y), bf_hi(la.y)}, bv = {bf_lo(bb.x), bf_hi(bb.x), bf_lo(bb.y), bf_hi(bb.y)}, gv = {bf_lo(gg.x), bf_hi(gg.x), bf_lo(gg.y), bf_hi(gg.y)};
#pragma unroll
            for (int j = 0; j < 4; ++j) { const float a = fast_exp2(l[j]); h[j] = a * h[j] + __builtin_amdgcn_sqrtf(1.0f - a * a) * bv[j]; }
            u32x2 w; w.x = cvt_pk_bf16(h[0] * gv[0], h[1] * gv[1]); w.y = cvt_pk_bf16(h[2] * gv[2], h[3] * gv[3]); *(u32x2*)(Y + o) = w; } }
}

__device__ __forceinline__ void p13_mid(const In& in, unsigned char* ws, float* out, LAS unsigned char* lds, int vcu, int G) {
    const int tid = threadIdx.x, lane = tid & 63, wave = __builtin_amdgcn_readfirstlane(tid >> 6);
    const int gw = vcu * NWAVES + wave, NGW = G * NWAVES;
    const float* MOD = (const float*)(ws + WS_CTL) + CW_MOD; const bf16* Y1 = (const bf16*)(ws + WS_Y1); bf16* H2 = (bf16*)(ws + WS_H2);
    const int RW = (NTOK + NGW - 1) / NGW, r0 = gw * RW, r1 = (r0 + RW < NTOK) ? r0 + RW : NTOK;
    f32x4 pg1[4], pg2[4], pgm[4], psh[4], psc[4]; int bcur = -1;
#pragma unroll
    for (int j = 0; j < 4; ++j) { const int col = 256 * j + 4 * lane; pg1[j] = *(const f32x4*)(in.norm_gain + 1024 + col); pg2[j] = *(const f32x4*)(in.norm_gain + 2048 + col); pgm[j] = pg1[j]; psh[j] = pg1[j]; psc[j] = pg1[j]; }
    for (int m0 = r0; m0 < r1; m0 += 2) {
        f32x4 v[2][4], xv[2][4]; int mr[2];
#pragma unroll
        for (int q = 0; q < 2; ++q) { mr[q] = (m0 + q < r1) ? m0 + q : m0;
            const u32x2* yr = (const u32x2*)(Y1 + (size_t)mr[q] * DM) + lane; const f32x4* xr = (const f32x4*)(in.x + (size_t)mr[q] * DM) + lane;
#pragma unroll
            for (int j = 0; j < 4; ++j) { const u32x2 w = yr[64 * j]; v[q][j] = (f32x4){bf_lo(w.x), bf_hi(w.x), bf_lo(w.y), bf_hi(w.y)}; xv[q][j] = xr[64 * j]; } }
#pragma unroll
        for (int q = 0; q < 2; ++q) { const int mrow = mr[q], b = mrow >> 13; float s2 = 0.f;
            if (q == 1 && m0 + 1 >= r1) continue;
            if (b != bcur) { bcur = b;
#pragma unroll
                for (int j = 0; j < 4; ++j) { const int col = 256 * j + 4 * lane; pgm[j] = *(const f32x4*)(MOD + b * 6144 + 2048 + col); psh[j] = *(const f32x4*)(MOD + b * 6144 + 3072 + col); psc[j] = *(const f32x4*)(MOD + b * 6144 + 4096 + col) + 1.0f; } }
#pragma unroll
            for (int j = 0; j < 4; ++j) s2 += (v[q][j].x * v[q][j].x + v[q][j].y * v[q][j].y) + (v[q][j].z * v[q][j].z + v[q][j].w * v[q][j].w);
            const float rstd = 1.0f / sqrtf(wave_sum(s2) * (1.f / DM) + EPSN); float s3 = 0.f;
            u64* x8 = (u64*)((bf16*)(ws + WS_X1B) + (size_t)mrow * DM) + lane;
#pragma unroll
            for (int j = 0; j < 4; ++j) {
                v[q][j] = xv[q][j] + pgm[j] * (v[q][j] * rstd * pg1[j]); x8[64 * j] = (u64)cvt_pk_bf16(v[q][j].x, v[q][j].y) | ((u64)cvt_pk_bf16(v[q][j].z, v[q][j].w) << 32); s3 += (v[q][j].x * v[q][j].x + v[q][j].y * v[q][j].y) + (v[q][j].z * v[q][j].z + v[q][j].w * v[q][j].w); }
            const float rstd2 = 1.0f / sqrtf(wave_sum(s3) * (1.f / DM) + EPSN);
            u64* o8 = (u64*)(H2 + (size_t)mrow * DM) + lane;
#pragma unroll
            for (int j = 0; j < 4; ++j) {
                const f32x4 r = (v[q][j] * rstd2 * pg2[j]) * psc[j] + psh[j]; o8[64 * j] = (u64)cvt_pk_bf16(r.x, r.y) | ((u64)cvt_pk_bf16(r.z, r.w) << 32);
                ((unsigned*)(ws + WS_H2F8 + (size_t)mrow * DM))[64 * j + lane] = cvt4_fp8(clamp_e4m3(r.x), clamp_e4m3(r.y), clamp_e4m3(r.z), clamp_e4m3(r.w)); } } }
    LAS float* scr = (LAS float*)(lds + wave * 16384);
    for (int it = gw; it < NEXP * 384; it += NGW) { const int e = it / 384, r = it % 384, which = r >> 7, sub = r & 127;
        if (which == 0) tr_item_fp8(in.w_exp_gate + (size_t)e * 1024 * 256, 256, 256, (unsigned char*)(ws + WS_WEGU8) + (size_t)e * 512 * 1024, 1024, 128, 256, 0, 32.0f, scr, sub >> 3, sub & 7, lane);
        else if (which == 1) tr_item_fp8(in.w_exp_up + (size_t)e * 1024 * 256, 256, 256, (unsigned char*)(ws + WS_WEGU8) + (size_t)e * 512 * 1024, 1024, 128, 256, 128, 32.0f, scr, sub >> 3, sub & 7, lane);
        else tr_item_fp8(in.w_exp_down + (size_t)e * 256 * 1024, 1024, 1024, (unsigned char*)(ws + WS_WED8) + (size_t)e * 1024 * 256, 256, 1 << 30, 0, 0, 32.0f, scr, sub >> 5, sub & 31, lane); }
}

__device__ __forceinline__ void route_tile(const In& in, unsigned char* ws, int t0, int wave, int lane, unsigned& mycount) {
    const float* LG = (const float*)(ws + WS_LOGITS); int* SEL = (int*)(ws + WS_TOKSEL); float* TW = (float*)(ws + WS_TOKW);
    const float rb = in.router_bias[lane];
    float lg[4];
    for (int tok = t0 + wave, i4 = 0; tok < t0 + 256; tok += NWAVES, i4 = (i4 + 1) & 3) {
        if (i4 == 0) {
#pragma unroll
            for (int u = 0; u < 4; ++u) lg[u] = LG[(size_t)(tok + u * NWAVES < t0 + 256 ? tok + u * NWAVES : tok) * 64 + lane]; }
        const float lgc = i4 == 0 ? lg[0] : (i4 == 1 ? lg[1] : (i4 == 2 ? lg[2] : lg[3]));
        const float s = 1.0f / (1.0f + __expf(-lgc)), ss = s + rb;
        int rk8 = 0;
#pragma unroll
        for (int j = 0; j < 8; ++j) { const float o = __shfl(ss, (lane & ~7) + j); rk8 += (o > ss || (o == ss && j < (lane & 7))) ? 1 : 0; }
        float gsum = rk8 < 2 ? ss : 0.f; gsum += __shfl_xor(gsum, 1); gsum += __shfl_xor(gsum, 2); gsum += __shfl_xor(gsum, 4);
        int rkg = 0; const int g = lane >> 3;
#pragma unroll
        for (int j = 0; j < 8; ++j) { const float o = __shfl(gsum, 8 * j); rkg += (o > gsum || (o == gsum && j < g)) ? 1 : 0; }
        const float msk = rkg < 4 ? ss : -INFINITY;
        int rk = 0;
#pragma unroll
        for (int j = 0; j < 64; ++j) { const float o = __builtin_bit_cast(float, __builtin_amdgcn_readlane(__builtin_bit_cast(int, msk), j)); rk += (o > msk || (o == msk && j < lane)) ? 1 : 0; }
        const bool sel = rk < 8;
        const float wsum = wave_sum(sel ? s : 0.f);
        if (sel) { SEL[(size_t)tok * 8 + rk] = lane; TW[(size_t)tok * 8 + rk] = s * 2.5f / wsum; ++mycount; }
    }
}

__device__ __forceinline__ void p16_fill(unsigned char* ws, LAS unsigned char* lds, int vcu, int G) {
    int tid = threadIdx.x; asm volatile("" : "+v"(tid));
    LAS unsigned* hist = (LAS unsigned*)lds; LAS unsigned* basev = hist + 64; LAS unsigned* pstart = hist + 128; LAS unsigned* cnts = hist + 256;
    unsigned* CTL = (unsigned*)(ws + WS_CTL); const int* SEL = (const int*)(ws + WS_TOKSEL); const float* TW = (const float*)(ws + WS_TOKW);
    int* LT = (int*)(ws + WS_LISTTOK); float* LW = (float*)(ws + WS_LISTW); int* TE = (int*)(ws + WS_TILEE); int* LP = (int*)(ws + WS_LISTP);
    if (tid < 64) { hist[tid] = 0u; cnts[tid] = CTL[CW_CNT + tid]; }
    __syncthreads();
    if (tid == 0) { unsigned acc = 0; for (int e = 0; e < 64; ++e) { pstart[e] = acc; acc += (cnts[e] + 255u) & ~255u; } pstart[64] = acc; }
    __syncthreads();
    if (vcu == 0) {
        if (tid == 0) CTL[CW_NT] = pstart[64] >> 8;
        for (int e = tid >> 3; e < 64; e += 64) { for (unsigned p = pstart[e] + cnts[e] + (tid & 7); p < pstart[e + 1]; p += 8) { LT[p] = 0; LW[p] = 0.f; LP[p] = -1; } }
        for (unsigned t = tid; t < (pstart[64] >> 8); t += NTHR) { int e = 0; for (int q = 0; q < 64; ++q) if ((t << 8) >= pstart[q]) e = q; TE[t] = e; }
    }
    const int per = (NTOK + G - 1) / G, t0 = vcu * per, t1 = (t0 + per < NTOK) ? t0 + per : NTOK;
    for (int p = t0 * 8 + tid; p < t1 * 8; p += NTHR) lds_add(&hist[SEL[p]], 1u);
    __syncthreads();
    if (tid < 64) { basev[tid] = hist[tid] ? atomicAdd(CTL + CW_CUR + tid, hist[tid]) : 0u; }
    __syncthreads();
    if (tid < 64) hist[tid] = 0u;
    __syncthreads();
    for (int p = t0 * 8 + tid; p < t1 * 8; p += NTHR) { const int e = SEL[p]; const unsigned slot = pstart[e] + basev[e] + lds_add(&hist[e], 1u); LT[slot] = p >> 3; LW[slot] = TW[p]; LP[slot] = p; }
    __syncthreads();
}

__device__ __forceinline__ void p19_final(const In& in, unsigned char* ws, float* out, int vcu, int G) {
    const int tid = threadIdx.x, lane = tid & 63, wave = __builtin_amdgcn_readfirstlane(tid >> 6);
    const int gw = vcu * NWAVES + wave, NGW = G * NWAVES;
    const float* MOD = (const float*)(ws + WS_CTL) + CW_MOD;
    f32x4 pg[4], pgf[4]; int bcur = -1;
#pragma unroll
    for (int j = 0; j < 4; ++j) { pg[j] = *(const f32x4*)(in.norm_gain + 3072 + 512 * (j >> 1) + 8 * lane + 4 * (j & 1)); pgf[j] = pg[j]; }
    for (int m0 = gw; m0 < NTOK; m0 += 2 * NGW) {
        int mr[2]; u32x4 xw[2][2]; u32x2 sv[2][9][2];
#pragma unroll
        for (int q = 0; q < 2; ++q) { mr[q] = (m0 + q * NGW < NTOK) ? m0 + q * NGW : m0; const int mrow = mr[q];
            const u32x4* xb = (const u32x4*)((const bf16*)(ws + WS_X1B) + (size_t)mrow * DM) + lane;
#pragma unroll
            for (int j = 0; j < 2; ++j) xw[q][j] = xb[64 * j];
#pragma unroll
            for (int k = 0; k < 9; ++k) { const u32x2* sr = (const u32x2*)(k < 8 ? slot_row(ws, mrow * 8 + k) : ws + WS_Y2 + (size_t)mrow * DM) + lane;
#pragma unroll
                for (int j = 0; j < 2; ++j) sv[q][k][j] = sr[64 * j]; } }
#pragma unroll
        for (int q = 0; q < 2; ++q) { const int mrow = mr[q], b = mrow >> 13;
            if (q == 1 && m0 + NGW >= NTOK) continue;
            if (b != bcur) { bcur = b;
#pragma unroll
                for (int j = 0; j < 4; ++j) pgf[j] = *(const f32x4*)(MOD + b * 6144 + 5120 + 512 * (j >> 1) + 8 * lane + 4 * (j & 1)); }
            f32x4 v[4], x1v[4]; float s2 = 0.f;
#pragma unroll
            for (int j = 0; j < 2; ++j) unpack8(xw[q][j], x1v[2 * j], x1v[2 * j + 1]);
#pragma unroll
            for (int j = 0; j < 4; ++j) { f32x4 rs = {0.f, 0.f, 0.f, 0.f};
#pragma unroll
                for (int k = 0; k < 9; ++k) { const int kk = (k + 8) % 9; const int w = (int)((j & 1) ? sv[q][kk][j >> 1].y : sv[q][kk][j >> 1].x);     rs[0] += __builtin_amdgcn_cvt_f32_fp8(w, 0); rs[1] += __builtin_amdgcn_cvt_f32_fp8(w, 1); rs[2] += __builtin_amdgcn_cvt_f32_fp8(w, 2); rs[3] += __builtin_amdgcn_cvt_f32_fp8(w, 3); }
                v[j] = rs * 0.125f; }
#pragma unroll
            for (int j = 0; j < 4; ++j) s2 += (v[j].x * v[j].x + v[j].y * v[j].y) + (v[j].z * v[j].z + v[j].w * v[j].w);
            const float rstd = 1.0f / sqrtf(wave_sum(s2) * (1.f / DM) + EPSN);
            f32x4* o4 = (f32x4*)(out + (size_t)mrow * DM) + 2 * lane;
#pragma unroll
            for (int j = 0; j < 4; ++j) o4[128 * (j >> 1) + (j & 1)] = x1v[j] + pgf[j] * (v[j] * rstd * pg[j]); } }
}

__device__ __forceinline__ int crow(int r, int hi) { return (r & 3) + 8 * (r >> 2) + 4 * hi; }
constexpr int IX_QS = 0, IX_H1 = 69632, IX_H2 = 102400, IX_TAB = 135168, IX_WL = 138240;

__device__ __forceinline__ void lds_inc(LAS unsigned* p) { (void)__hip_atomic_fetch_add(p, 1u, __ATOMIC_RELAXED, __HIP_MEMORY_SCOPE_WORKGROUP); }
__device__ __forceinline__ unsigned suffix_incl(unsigned v, int lane) {
#pragma unroll
    for (int off = 1; off < 64; off <<= 1) { const unsigned t = __shfl_down(v, off); if (lane + off < 64) v += t; }
    return v;
}
__device__ __forceinline__ void find_bins(LAS unsigned* hist, int wave, int lane, const int (&need)[4], LAS int* out_bin, LAS int* out_above) {
#pragma unroll
    for (int qq = 0; qq < 4; ++qq) { const int q = wave * 4 + qq;
        unsigned cj[4]; unsigned tot = 0;
#pragma unroll
        for (int j = 0; j < 4; ++j) { cj[j] = hist[(4 * lane + j) * 32 + q]; tot += cj[j]; }
        unsigned cum = suffix_incl(tot, lane) - tot;
#pragma unroll
        for (int j = 3; j >= 0; --j) { if ((int)cum < need[qq] && (int)(cum + cj[j]) >= need[qq]) { out_bin[q] = 4 * lane + j; out_above[q] = (int)cum; } cum += cj[j]; } }
}

__device__ __forceinline__ void p8_indexer(unsigned char* ws, LAS unsigned char* lds, int vcu, int G) {
    const int wave = __builtin_amdgcn_readfirstlane(threadIdx.x >> 6);
    const bf16* QI = (const bf16*)(ws + WS_QI); const bf16* KI = (const bf16*)(ws + WS_KI); const float* WI = (const float*)(ws + WS_WI);
    unsigned* SCR = (unsigned*)(ws + WS_SCR) + (size_t)vcu * 131072;
    LAS unsigned* H1 = (LAS unsigned*)(lds + IX_H1); LAS unsigned* H2 = (LAS unsigned*)(lds + IX_H2);
    LAS int* TB1 = (LAS int*)(lds + IX_TAB); LAS int* TAB = TB1 + 32; LAS int* TTHR = TB1 + 64; LAS int* TN3 = TB1 + 96; LAS int* TAB2 = TB1 + 128; LAS int* TV = TB1 + 160; LAS unsigned* CNT = (LAS unsigned*)(TB1 + 192);
    const int nrounds = (1024 + G - 1) / G;
    for (int rnd = 0; rnd < nrounds; ++rnd) {
        int tid = threadIdx.x; asm volatile("" : "+v"(tid));
        const int lane = tid & 63, c = lane & 31, hi = lane >> 5;
        const int ui = rnd * G + ((rnd & 1) ? (G - 1 - vcu) : vcu);
        if (ui >= 1024) continue;
        const int qg = 255 - (ui >> 2), b = ui & 3, t0 = qg * 32; const size_t rowbase = (size_t)b * SEQ;
        unsigned* MK = (unsigned*)(ws + WS_MASK) + ((size_t)(b * 256 + qg) * 128) * 64;
        if (qg < 8) {
            if (wave == 0) {
                for (int j = 0; j < 4; ++j) { unsigned W = 0u;
#pragma unroll
                    for (int r = 0; r < 16; ++r) { const int k0 = 64 * j + crow(r, hi), k1 = k0 + 32; W |= (k0 <= t0 + c ? 1u : 0u) << r; W |= (k1 <= t0 + c ? 1u : 0u) << (16 + r); }
                    unsigned ow = 0u;
#pragma unroll
                    for (int m = 0; m < 32; ++m) { const unsigned long long B = __ballot((W >> m) & 1u); const unsigned v = (lane & 1) ? (unsigned)(B >> 32) : (unsigned)B; ow = ((lane >> 1) == m) ? v : ow; }
                    MK[j * 64 + lane] = ow; }
            }
            continue;
        }
#pragma unroll
        for (int i = 0; i < 8; ++i) { const int j = tid + 512 * i, n = j & 31, rest = j >> 5, g = rest & 1, ks = (rest >> 1) & 3, h = rest >> 3;
            const u32x4 v = *(const u32x4*)(QI + (rowbase + t0 + n) * 1024 + h * 64 + ks * 16 + g * 8);
            *(LAS u32x4*)(lds + IX_QS + ((h * 4 + ks) * 2 + g) * 512 + n * 16) = v; }
#pragma unroll
        for (int i = 0; i < 32; ++i) H1[tid + 512 * i] = 0u;
        ((LAS float*)(lds + IX_WL))[tid] = WI[(rowbase + t0 + (tid & 31)) * 16 + (tid >> 5)];
        __syncthreads();
        { const int n = tid & 31, d0 = (tid >> 5) * 4, ks = d0 >> 4, g = (d0 >> 3) & 1;
            float a0 = 0.f, a1 = 0.f, a2 = 0.f, a3 = 0.f;
#pragma unroll
            for (int h = 0; h < 16; ++h) { const float w = WI[(rowbase + t0 + n) * 16 + h]; const u32x2 qv = *(const LAS u32x2*)(lds + IX_QS + ((h * 4 + ks) * 2 + g) * 512 + n * 16 + (d0 & 7) * 2);
                a0 += w * bf_lo(qv.x); a1 += w * bf_hi(qv.x); a2 += w * bf_lo(qv.y); a3 += w * bf_hi(qv.y); }
            u32x2 o; o.x = cvt_pk_bf16(a0, a1); o.y = cvt_pk_bf16(a2, a3);
            *(LAS u32x2*)(lds + IX_QS + ((16 * 4 + ks) * 2 + g) * 512 + n * 16 + (d0 & 7) * 2) = o; }
        __syncthreads();
        const int ngroups = (qg >> 2) + 1;
        for (int it = wave; it < ngroups; it += 8) {
            bf16x8 kf[4][4];
#pragma unroll
            for (int tile = 0; tile < 4; ++tile) { const int kt = 4 * it + tile, ktc = kt < qg ? kt : qg;
#pragma unroll
                for (int ks = 0; ks < 4; ++ks) kf[tile][ks] = *(const bf16x8*)(KI + (rowbase + 32 * ktc + c) * 64 + ks * 16 + hi * 8); }
            f32x16 sc[4];
#pragma unroll
            for (int tile = 0; tile < 4; ++tile)
#pragma unroll
                for (int r = 0; r < 16; ++r) sc[tile][r] = 0.f;
            bf16x8 bq[2][4]; f32x16 av[2]; float wq[2];
#define IX_LDQ(h_) do { _Pragma("unroll") for (int ks = 0; ks < 4; ++ks) bq[(h_) & 1][ks] = *(const LAS bf16x8*)(lds + IX_QS + (((h_) * 4 + ks) * 2 + hi) * 512 + c * 16); \
            wq[(h_) & 1] = ((const LAS float*)(lds + IX_WL))[((h_) & 15) * 32 + c]; } while (0)
            IX_LDQ(0);
#define IX_STEP(st) do { constexpr int h = (st) >> 1, pair = (st) & 1; \
                if (pair == 0 && h + 1 < 17) IX_LDQ(h + 1); \
                _Pragma("unroll") for (int r = 0; r < 16; ++r) { av[0][r] = 0.f; av[1][r] = 0.f; } \
                _Pragma("unroll") for (int ks = 0; ks < 4; ++ks) { av[0] = __builtin_amdgcn_mfma_f32_32x32x16_bf16(kf[2 * pair][ks], bq[h & 1][ks], av[0], 0, 0, 0); \
                    av[1] = __builtin_amdgcn_mfma_f32_32x32x16_bf16(kf[2 * pair + 1][ks], bq[h & 1][ks], av[1], 0, 0, 0); } \
                if (h < 16) { _Pragma("unroll") for (int r = 0; r < 16; ++r) { sc[2 * pair][r] = __builtin_fmaf(__builtin_fabsf(av[0][r]), wq[h & 1], sc[2 * pair][r]); sc[2 * pair + 1][r] = __builtin_fmaf(__builtin_fabsf(av[1][r]), wq[h & 1], sc[2 * pair + 1][r]); } } \
                else { _Pragma("unroll") for (int r = 0; r < 16; ++r) { sc[2 * pair][r] += av[0][r]; sc[2 * pair + 1][r] += av[1][r]; } } \
                __builtin_amdgcn_sched_barrier(0); } while (0)
#define IX_STEP2(s) IX_STEP((s)); IX_STEP((s) + 1)
            IX_STEP2(0); IX_STEP2(2); IX_STEP2(4); IX_STEP2(6); IX_STEP2(8); IX_STEP2(10); IX_STEP2(12); IX_STEP2(14); IX_STEP2(16);
            IX_STEP2(18); IX_STEP2(20); IX_STEP2(22); IX_STEP2(24); IX_STEP2(26); IX_STEP2(28); IX_STEP2(30); IX_STEP2(32);
#undef IX_STEP2
#undef IX_STEP
#undef IX_LDQ
            if (4 * it + 3 < qg) {
                asm volatile("; keys of a group below the diagonal" ::: "memory");
#pragma unroll
            for (int tile = 0; tile < 4; ++tile) { const int kt = 4 * it + tile;
#pragma unroll
                for (int rq = 0; rq < 2; ++rq) { u32x4 pq;
#pragma unroll
                    for (int j = 0; j < 4; ++j) { const int rp = 4 * rq + j, r0 = 2 * rp;
                        unsigned p = __builtin_bit_cast(unsigned, __builtin_amdgcn_cvt_pkrtz(sc[tile][r0], sc[tile][r0 + 1]));
                        p ^= 0x80008000u | __builtin_bit_cast(unsigned, __builtin_bit_cast(s16x2, p) >> (short)15);
                        lds_inc(H1 + ((p >> 8) & 255u) * 32 + c); lds_inc(H1 + (p >> 24) * 32 + c);
                        pq[j] = p; }
                    *(u32x4*)(SCR + ((size_t)((it * 8 + tile * 2 + rq) * 64 + lane)) * 4) = pq; } }
            } else {
                asm volatile("; keys of the diagonal group" ::: "memory");
#pragma unroll
            for (int tile = 0; tile < 4; ++tile) { const int kt = 4 * it + tile;
#pragma unroll
                for (int rq = 0; rq < 2; ++rq) { u32x4 pq;
#pragma unroll
                    for (int j = 0; j < 4; ++j) { const int rp = 4 * rq + j, r0 = 2 * rp;
                        unsigned p = __builtin_bit_cast(unsigned, __builtin_amdgcn_cvt_pkrtz(sc[tile][r0], sc[tile][r0 + 1]));
                        p ^= 0x80008000u | __builtin_bit_cast(unsigned, __builtin_bit_cast(s16x2, p) >> (short)15);
                        if (kt > qg) p = 0u;
                        else if (kt == qg) { if (crow(r0, hi) > c) p &= 0xffff0000u; if (crow(r0 + 1, hi) > c) p &= 0x0000ffffu; }
                        lds_inc(H1 + ((p >> 8) & 255u) * 32 + c); lds_inc(H1 + (p >> 24) * 32 + c);
                        pq[j] = p; }
                    *(u32x4*)(SCR + ((size_t)((it * 8 + tile * 2 + rq) * 64 + lane)) * 4) = pq; } }
            }
        }
        __syncthreads();
        int need[4];
#pragma unroll
        for (int qq = 0; qq < 4; ++qq) { const int nn = t0 + wave * 4 + qq + 1; need[qq] = nn < 256 ? nn : 256; }
        find_bins(H1, wave, lane, need, TB1, TAB);
        asm volatile("s_waitcnt vmcnt(0)" ::: "memory");
        __syncthreads();
        const unsigned b1 = (unsigned)TB1[c];
        for (int it = wave; it < ngroups; it += 8) { unsigned pv[32];
#pragma unroll
            for (int q4 = 0; q4 < 8; ++q4) { const u32x4 v4 = *(const u32x4*)(SCR + ((size_t)((it * 8 + q4) * 64 + lane)) * 4); pv[4 * q4] = v4.x; pv[4 * q4 + 1] = v4.y; pv[4 * q4 + 2] = v4.z; pv[4 * q4 + 3] = v4.w; }
#pragma unroll
            for (int s = 0; s < 32; ++s) { const unsigned p = pv[s];
                if (((p >> 8) & 255u) == b1) lds_inc(H2 + (p & 255u) * 32 + c);
                if ((p >> 24) == b1) lds_inc(H2 + ((p >> 16) & 255u) * 32 + c); } }
        __syncthreads();
        int need2[4];
#pragma unroll
        for (int qq = 0; qq < 4; ++qq) need2[qq] = need[qq] - TAB[wave * 4 + qq];
        find_bins(H2, wave, lane, need2, TV, TAB2);
        __syncthreads();
        const unsigned thr = (b1 << 8) | (unsigned)TV[c];
        const int needc = (t0 + c + 1) < 256 ? (t0 + c + 1) : 256;
        const int ties_take = needc - TAB[c] - TAB2[c];
        unsigned cnt = 0;
        for (int it = wave; it < ngroups; it += 8) { unsigned pv[32];
#pragma unroll
            for (int q4 = 0; q4 < 8; ++q4) { const u32x4 v4 = *(const u32x4*)(SCR + ((size_t)((it * 8 + q4) * 64 + lane)) * 4); pv[4 * q4] = v4.x; pv[4 * q4 + 1] = v4.y; pv[4 * q4 + 2] = v4.z; pv[4 * q4 + 3] = v4.w; }
#pragma unroll
            for (int s = 0; s < 32; ++s) { const unsigned p = pv[s]; cnt += ((p & 0xffffu) == thr) ? 1u : 0u; cnt += ((p >> 16) == thr) ? 1u : 0u; } }
        CNT[wave * 64 + lane] = cnt;
        __syncthreads();
        int rank = 0;
        for (int w2 = 0; w2 < wave; ++w2) rank += (int)(CNT[w2 * 64 + c] + CNT[w2 * 64 + 32 + c]);
        if (hi) rank += (int)CNT[wave * 64 + c];
        for (int it = wave; it < ngroups; it += 8) { unsigned pv[32];
#pragma unroll
            for (int q4 = 0; q4 < 8; ++q4) { const u32x4 v4 = *(const u32x4*)(SCR + ((size_t)((it * 8 + q4) * 64 + lane)) * 4); pv[4 * q4] = v4.x; pv[4 * q4 + 1] = v4.y; pv[4 * q4 + 2] = v4.z; pv[4 * q4 + 3] = v4.w; }
            unsigned W[2] = {0u, 0u};
#pragma unroll
            for (int tile = 0; tile < 4; ++tile) {
#pragma unroll
                for (int rp = 0; rp < 8; ++rp) { const unsigned p = pv[tile * 8 + rp];
                    const unsigned k0 = p & 0xffffu, k1 = p >> 16;
                    const bool s0 = k0 > thr || (k0 == thr && rank < ties_take); if (k0 == thr) ++rank;
                    const bool s1 = k1 > thr || (k1 == thr && rank < ties_take); if (k1 == thr) ++rank;
                    const unsigned long long B0 = __ballot(s0), B1 = __ballot(s1); const int m0 = (tile & 1) * 16 + 2 * rp;
                    const unsigned v0 = (lane & 1) ? (unsigned)(B0 >> 32) : (unsigned)B0, v1 = (lane & 1) ? (unsigned)(B1 >> 32) : (unsigned)B1;
                    W[tile >> 1] = ((lane >> 1) == m0) ? v0 : (((lane >> 1) == m0 + 1) ? v1 : W[tile >> 1]); } }
            MK[(2 * it) * 64 + lane] = W[0]; MK[(2 * it + 1) * 64 + lane] = W[1]; }
        __syncthreads();
    }
}

constexpr int AT_K = 0, AT_TB = 8192, AT_V = 4 * 8192, AT_BIAS = 8 * 8192;
__device__ __forceinline__ unsigned pk4_fp8(float a, float b, float c, float d) { int w = __builtin_amdgcn_cvt_pk_fp8_f32(a, b, 0, false); w = __builtin_amdgcn_cvt_pk_fp8_f32(c, d, w, true); return (unsigned)w; }
__device__ __forceinline__ unsigned pk4_fp8t(float a, float b, float c, float d) { int w = __builtin_amdgcn_cvt_pk_fp8_f32(a, b, __builtin_bit_cast(int, a), false); w = __builtin_amdgcn_cvt_pk_fp8_f32(c, d, w, true); return (unsigned)w; }
__device__ __forceinline__ pg8::i32x8 ld_frag8(const LAS unsigned char* base, int off) {
    const u32x4 a = *(const LAS u32x4*)(base + off), b = *(const LAS u32x4*)(base + (off ^ 16)); return (pg8::i32x8){(int)a.x, (int)a.y, (int)a.z, (int)a.w, (int)b.x, (int)b.y, (int)b.z, (int)b.w}; }
#define MFMA8(A, B, C) __builtin_amdgcn_mfma_scale_f32_32x32x64_f8f6f4(A, B, C, 0, 0, 0, 0, 0, 0)

__device__ __forceinline__ void p9_attention(const In& in, unsigned char* ws, const unsigned char* kvb, LAS unsigned char* lds, int vcu, int G) {
    const int tid = threadIdx.x, lane = tid & 63, wave = __builtin_amdgcn_readfirstlane(tid >> 6), c = lane & 31, hi = lane >> 5;
    const unsigned char* Q = ws + WS_Q; const unsigned char* Kp = kvb + OUT_K; const unsigned char* VT = kvb + OUT_VT; unsigned char* YA = ws + WS_YATT;
    const unsigned* MASK = (const unsigned*)(ws + WS_MASK);
    LAS float* BIAS = (LAS float*)(lds + AT_BIAS);
    const float NEG = -INFINITY;
    const int nrounds = (1024 + G - 1) / G;
    for (int rnd = 0; rnd < nrounds; ++rnd) {
        int qb, bh;
        if (G == 256) {
            const int xcd = vcu >> 5, w5 = vcu & 31, p = w5 & 15; bh = (rnd >> 1) * 16 + xcd * 2 + (w5 >> 4); qb = (rnd & 1) ? p : 31 - p;
        } else { const int ui = rnd * G + ((rnd & 1) ? (G - 1 - vcu) : vcu); if (ui >= 1024) continue; qb = 31 - (ui >> 5); bh = ui & 31; }
        const int b = bh >> 3, h = bh & 7;
        __syncthreads();
        if (tid < 128) { int bk = tid; if (tid >= 16) { bk = 16 + (int)(__log2f((float)tid * 0.0625f) * 5.3333333f); bk = bk > 31 ? 31 : bk; } BIAS[tid] = LOG2E * in.rel_bias[bk * 8 + h]; }
        const float cfar = LOG2E * in.rel_bias[31 * 8 + h];
        const int tq0 = 256 * qb + 32 * wave, t = tq0 + c, qg = tq0 >> 5;
        pg8::i32x8 qf[2];
#pragma unroll
        for (int ks = 0; ks < 2; ++ks) { const u32x4* qp = (const u32x4*)(Q + ((size_t)(b * SEQ + t)) * 1024 + h * 128 + ks * 64 + hi * 32); const u32x4 x = qp[0], y = qp[1];
            qf[ks] = (pg8::i32x8){(int)x.x, (int)x.y, (int)x.z, (int)x.w, (int)y.x, (int)y.y, (int)y.z, (int)y.w}; }
        f32x16 oacc[4];
#pragma unroll
        for (int db = 0; db < 4; ++db)
#pragma unroll
            for (int r = 0; r < 16; ++r) oacc[db][r] = 0.f;
        float m_run = -1e30f, l_run = 0.f;
        const int ntile = 4 * (qb + 1);
        const int krow_ = 8 * wave + (lane >> 3), vrow_ = 16 * wave + (lane >> 2);
        const unsigned char* ksrc = Kp + ((size_t)(b * SEQ + krow_)) * 1024 + h * 128 + (((lane & 7) ^ ((krow_ >> 1) & 7)) * 16);
        const unsigned char* vsrc = VT + ((size_t)(h * 128 + vrow_)) * NTOK + b * SEQ + (((lane & 3) ^ ((vrow_ >> 2) & 3)) * 16);
#define AT_DMA(j, buf) do { \
            __builtin_amdgcn_global_load_lds((const unsigned*)(ksrc + (size_t)(64 * (j)) * 1024), (LAS unsigned*)(lds + AT_K + (buf) * AT_TB + wave * 1024), 16, 0, 0); \
            __builtin_amdgcn_global_load_lds((const unsigned*)(vsrc + 64 * (j)), (LAS unsigned*)(lds + AT_V + (buf) * AT_TB + wave * 1024), 16, 0, 0); } while (0)
        const unsigned long long* mrow = (const unsigned long long*)(MASK + (((size_t)(b * 256 + qg)) * 128) * 64);
        u64x8 mk0, mk1, mk2, mk3;
#define AT_MLOAD(j, dep) asm volatile("s_load_dwordx16 %0, %4, 0x0\n\ts_load_dwordx16 %1, %4, 0x40\n\ts_load_dwordx16 %2, %4, 0x80\n\ts_load_dwordx16 %3, %4, 0xc0" \
            : "=&s"(mk0), "=&s"(mk1), "=&s"(mk2), "=&s"(mk3) : "s"(mrow + (size_t)(j) * 32), "v"(dep) : "memory")
        AT_MLOAD(0, tid);
#pragma unroll
        for (int ks = 0; ks < 2; ++ks) asm volatile("" :: "v"(qf[ks]));
        asm volatile("s_waitcnt vmcnt(0)" ::: "memory");
        AT_DMA(0, 0); AT_DMA(1, 1); AT_DMA(2, 2);
        asm volatile("s_waitcnt vmcnt(2)" ::: "memory");
        asm volatile("s_waitcnt lgkmcnt(0)" : "+s"(mk0), "+s"(mk1), "+s"(mk2), "+s"(mk3) :: "memory");
        __builtin_amdgcn_s_barrier();
        const int koff = c * 128 + (((2 * hi) ^ ((c >> 1) & 7)) << 4), voff = c * 64 + (((2 * hi) ^ ((c >> 2) & 3)) << 4);
        const int jw = (tq0 + 31) >> 6;
        pg8::i32x8 kf[4];
        kf[0] = ld_frag8(lds + AT_K, koff); kf[1] = ld_frag8(lds + AT_K, koff ^ 64); kf[2] = ld_frag8(lds + AT_K + 4096, koff); kf[3] = ld_frag8(lds + AT_K + 4096, koff ^ 64);
        for (int j = 0; j < ntile; ++j) {
            const int buf = j & 3;
            if (j <= jw) {
                f32x16 p0, p1;
                {
                    const f32x16 z = {0.f, 0.f, 0.f, 0.f, 0.f, 0.f, 0.f, 0.f, 0.f, 0.f, 0.f, 0.f, 0.f, 0.f, 0.f, 0.f};
                    p0 = MFMA8(kf[0], qf[0], z); p1 = MFMA8(kf[2], qf[0], z); p0 = MFMA8(kf[1], qf[1], p0); p1 = MFMA8(kf[3], qf[1], p1);
                }
                pg8::i32x8 vf[4];
                { const LAS unsigned char* vb = lds + AT_V + buf * AT_TB;
#pragma unroll
                  for (int db = 0; db < 4; ++db) vf[db] = ld_frag8(vb + db * 2048, voff); }
                if (j < jw) { const LAS unsigned char* kn = lds + AT_K + ((j + 1) & 3) * AT_TB;
                    kf[0] = ld_frag8(kn, koff); kf[1] = ld_frag8(kn, koff ^ 64); kf[2] = ld_frag8(kn + 4096, koff); kf[3] = ld_frag8(kn + 4096, koff ^ 64); }
                const int dmin = tq0 - (64 * j + 63);
                float boff = cfar;
                if (dmin < 113) { boff = 0.f;
#pragma unroll
                    for (int r = 0; r < 16; ++r) { int d0 = t - (64 * j + crow(r, hi)), d1 = d0 - 32; d0 = d0 < 0 ? 0 : (d0 > 127 ? 127 : d0); d1 = d1 < 0 ? 0 : (d1 > 127 ? 127 : d1); p0[r] += BIAS[d0]; p1[r] += BIAS[d1]; }
                }
                {
                    const float touch = p0[0] + p1[0];
#define AT_SELM(P, r, M) do { float o_; asm("v_cndmask_b32_e64 %0, %1, %2, %3" : "=v"(o_) : "v"(NEG), "v"(P[r]), "s"(M), "v"(touch)); P[r] = o_; } while (0)
#pragma unroll
                    for (int r = 0; r < 8; ++r) { AT_SELM(p0, r, mk0[r]); AT_SELM(p0, 8 + r, mk1[r]); AT_SELM(p1, r, mk2[r]); AT_SELM(p1, 8 + r, mk3[r]); }
#undef AT_SELM
                }
                float mx = fmaxf(fmaxf(p0[0], p0[1]), p1[0]);
#pragma unroll
                for (int r = 2; r < 16; r += 2) mx = fmaxf(fmaxf(mx, p0[r]), p0[r + 1]);
#pragma unroll
                for (int r = 1; r < 15; r += 2) mx = fmaxf(fmaxf(mx, p1[r]), p1[r + 1]);
                mx = fmaxf(mx, p1[15]);
                mx = fmaxf(mx, __shfl_xor(mx, 32)) + boff;
                AT_MLOAD(j + 1 < 128 ? j + 1 : 127, mx);
                const float m_new = (mx > m_run + 2.0f) ? mx : m_run, alpha = fast_exp2(m_run - m_new); m_run = m_new;
                const float sub = m_new - boff - 6.0f;
                const f32x2 ns2 = {-sub, -sub};
                f32x2 s2a = {0.f, 0.f}, s2b = {0.f, 0.f}, q[16];
#pragma unroll
                for (int i = 0; i < 8; ++i) { q[i] = (f32x2){p0[2 * i], p0[2 * i + 1]}; q[8 + i] = (f32x2){p1[2 * i], p1[2 * i + 1]}; }
#pragma unroll
                for (int i = 0; i < 16; i += 2) { f32x2 u = q[i], v = q[i + 1];
                    u = u + ns2; v = v + ns2;
                    u.x = fast_exp2(u.x); u.y = fast_exp2(u.y); v.x = fast_exp2(v.x); v.y = fast_exp2(v.y);
                    s2a = s2a + u; s2b = s2b + v;
                    q[i] = u; q[i + 1] = v; }
                l_run = l_run * alpha + ((s2a.x + s2b.x) + (s2a.y + s2b.y));
                if (!__all(alpha == 1.0f)) {
#pragma unroll
                    for (int db = 0; db < 4; ++db)
#pragma unroll
                        for (int r = 0; r < 16; ++r) oacc[db][r] *= alpha; }
                pg8::i32x8 pb;
#pragma unroll
                for (int i = 0; i < 4; ++i) { const unsigned a = pk4_fp8t(q[2 * i].x, q[2 * i].y, q[2 * i + 1].x, q[2 * i + 1].y), bq = pk4_fp8t(q[8 + 2 * i].x, q[8 + 2 * i].y, q[9 + 2 * i].x, q[9 + 2 * i].y);
                    const auto sw = __builtin_amdgcn_permlane32_swap(a, bq, false, false); pb[2 * i] = (int)sw[0]; pb[2 * i + 1] = (int)sw[1]; }
#pragma unroll
                for (int db = 0; db < 4; ++db) oacc[db] = MFMA8(vf[db], pb, oacc[db]);
            }
            if (j + 3 < ntile) AT_DMA(j + 3, (j + 3) & 3);
            if (j + 3 < ntile) asm volatile("s_waitcnt vmcnt(2)" ::: "memory"); else asm volatile("s_waitcnt vmcnt(0)" ::: "memory");
            asm volatile("s_waitcnt lgkmcnt(0)" ::: "memory");
            __builtin_amdgcn_s_barrier();
        }
        const float l = l_run + __shfl_xor(l_run, 32), inv = 1.0f / l;
        unsigned char* yrow = YA + ((size_t)(b * SEQ + t)) * 1024 + h * 128 + 16 * hi;
#pragma unroll
        for (int db = 0; db < 4; ++db) { unsigned w[4];
#pragma unroll
            for (int rg = 0; rg < 4; ++rg) w[rg] = pk4_fp8(clamp_e4m3(oacc[db][4 * rg] * inv), clamp_e4m3(oacc[db][4 * rg + 1] * inv), clamp_e4m3(oacc[db][4 * rg + 2] * inv), clamp_e4m3(oacc[db][4 * rg + 3] * inv));
            const auto sA = __builtin_amdgcn_permlane32_swap(w[0], w[2], false, false), sB = __builtin_amdgcn_permlane32_swap(w[1], w[3], false, false);
            *(u32x4*)(yrow + 32 * db) = (u32x4){sA[0], sA[1], sB[0], sB[1]}; }
#undef AT_DMA
#undef AT_MLOAD
    }
}

struct Args { In in; float* out; unsigned char* ws; int ph_lo, ph_hi; };
constexpr int N_PHASES = 20;

__global__ void __launch_bounds__(NTHR, 2) mk_fwd(Args args) {
    extern __shared__ __attribute__((aligned(16))) unsigned char lds_raw[];
    LAS unsigned char* lds = (LAS unsigned char*)lds_raw;
    const int tid = threadIdx.x;
    const int G = gridDim.x; int vcu; { const int bx = blockIdx.x; vcu = (G % 8 == 0) ? (bx % 8) * (G / 8) + bx / 8 : bx; }
    unsigned char* ws = args.ws; const In& in = args.in;
    volatile LAS unsigned* MISC = (volatile LAS unsigned*)(lds + LDSCTL_OFF);
    for (int u = tid; u < (LDS_BYTES - LDSCTL_OFF) / 4; u += NTHR) ((LAS unsigned*)(lds + LDSCTL_OFF))[u] = 0u;
    __syncthreads();
    XcdBarrier bar = xcd_barrier_post((unsigned*)(ws + WS_CTL) + CW_BAR, MISC + 8);
    const int lo = args.ph_lo, hi = args.ph_hi;
#ifdef ONLY
#define IN(k) ((k) == ONLY && lo <= (k) && (k) < hi)
#else
#define IN(k) (lo <= (k) && (k) < hi)
#endif
#define SEAM(k) do { if (IN(k) && IN((k) + 1)) xcd_barrier(bar); } while (0)
    const int cid = (int)blockIdx.x;

    if (IN(0)) { p0_prologue(in, ws, lds, vcu, G); } SEAM(0);
    if (IN(1)) { p1_norm_rows(in, ws, vcu, G); } SEAM(1);
    if (IN(2)) {
        pg8::DenseOrder S; S.init(ws + WS_H, ws + WS_WIN_T, NTOK, 2048, 1024, 1024, G, cid);
        EpiSplitBf16<0, 1> E{(bf16*)(ws + WS_URNN), (bf16*)(ws + WS_GGATE), 1024, 1024, 1.0f, 1.0f};
        pg8::gemm_phase<EpiSplitBf16<0, 1>, pg8::DenseOrder, true, true>(lds, pg8::Gemm{1024, 1024, 1024}, S, E);
    } SEAM(2);
    if (IN(3)) { p3_conv(in, ws, vcu, G); } SEAM(3);
    if (IN(4)) {
        pg8::DenseOrder S; S.init(ws + WS_XC, ws + WS_WG_T, NTOK, 2048, 1024, 256, G, cid); S.a_sh = 1; S.a_mul = 256 * 2;
        EpiGate E{(const bf16*)(ws + WS_XC), (bf16*)(ws + WS_LOGA), (bf16*)(ws + WS_BB), in.b_rg_a, in.b_rg_x, (const float*)(ws + WS_SPL)};
        pg8::gemm_phase<EpiGate, pg8::DenseOrder, true, true>(lds, pg8::Gemm{1024, 256, 256}, S, E);
    } SEAM(4);
    if (IN(5)) { p5_scan_local(ws, vcu, G); } SEAM(5);
    if (IN(6)) {
        p7_scan_final(ws, vcu, G);
        pg8::DenseOrder S; S.init(ws + WS_H, ws + WS_WIN_T + (size_t)C_QI * 1024 * 2, NTOK, 1280, 1024, 1024, G, cid);
        EpiIdx E{(bf16*)(ws + WS_QI), (bf16*)(ws + WS_KI), (float*)(ws + WS_WI)};
        pg8::gemm_phase<EpiIdx, pg8::DenseOrder, true, true>(lds, pg8::Gemm{1024, 1024, 1024}, S, E);
    } SEAM(6);
    if (IN(7)) { p8_indexer(ws, lds, vcu, G); }
    if (IN(8)) {
        { pg8::DenseOrder8 S; S.init(ws + WS_H8, ws + WS_WQKV8, NTOK, 2048, 512, 512, G, cid);
          EpiSplitF8 E{ws + WS_Q, (unsigned char*)args.out + OUT_K, 1024, 1024, QSCALE / 32.0f, 1.0f / 32.0f};
          pg8::gemm_phase<EpiSplitF8, pg8::DenseOrder8, true, true>(lds, pg8::Gemm{512, 512, 512}, S, E); }
        { pg8::DenseOrder8 S; S.init(ws + WS_WQKV8 + (size_t)2048 * 1024, ws + WS_H8, 1024, NTOK, 512, 512, G, cid);
          EpiSplitF8 E{(unsigned char*)args.out + OUT_VT, (unsigned char*)args.out + OUT_VT, NTOK, 1 << 30, 1.0f / 32.0f, 1.0f / 32.0f};
          pg8::gemm_phase<EpiSplitF8, pg8::DenseOrder8, true, true>(lds, pg8::Gemm{512, 512, 512}, S, E); }
    } SEAM(8);
    if (IN(9)) { p9_attention(in, ws, (const unsigned char*)args.out, lds, vcu, G);
        __syncthreads();
        { pg8::DenseOrder8 S; S.init(ws + WS_H8, ws + WS_WGL8, NTOK, 1024, 512, 512, G, cid);
          EpiSplitBf16<2, 2> E{(bf16*)(ws + WS_GLR), (bf16*)(ws + WS_GLR), 1024, 1 << 30, 1.0f / 32.0f, 1.0f / 32.0f};
          pg8::gemm_phase<EpiSplitBf16<2, 2>, pg8::DenseOrder8, true, true>(lds, pg8::Gemm{512, 512, 512}, S, E); }
        { pg8::DenseOrder8 S; S.init(ws + WS_H8, ws + WS_WGL8 + (size_t)1024 * 1024, NTOK, 1024, 512, 512, G, cid);
          EpiSplitBf16<2, 2> E{(bf16*)(ws + WS_GLA), (bf16*)(ws + WS_GLA), 1024, 1 << 30, 1.0f / 32.0f, 1.0f / 32.0f};
          pg8::gemm_phase<EpiSplitBf16<2, 2>, pg8::DenseOrder8, true, true>(lds, pg8::Gemm{512, 512, 512}, S, E); }
    } SEAM(9);
    if (IN(11)) {
        { pg8::DenseOrder S; S.init(ws + WS_YRNN, ws + WS_WBRR_T, NTOK, 1024, 1024, 1024, G, cid);
          EpiMerge<0> E{(bf16*)(ws + WS_M1), (const bf16*)(ws + WS_GLR), nullptr, 1.0f, 0.f};
          pg8::gemm_phase<EpiMerge<0>, pg8::DenseOrder, true, true>(lds, pg8::Gemm{1024, 1024, 1024}, S, E); }
        asm volatile("s_waitcnt vmcnt(0)" ::: "memory"); __syncthreads();
        { pg8::DenseOrder8 S; S.init(ws + WS_YATT, ws + WS_WBRA8, NTOK, 1024, 512, 512, G, cid);
          EpiMerge<2> E{(bf16*)(ws + WS_M1), (const bf16*)(ws + WS_GLA), ws + WS_M18, 1.0f / 32.0f, 0.f};
          pg8::gemm_phase<EpiMerge<2>, pg8::DenseOrder8, true, true>(lds, pg8::Gemm{512, 512, 512}, S, E); }
    } SEAM(11);
    if (IN(12)) {
        pg8::DenseOrder8 S; S.init(ws + WS_M18, ws + WS_WOUT8, NTOK, 1024, 512, 512, G, cid);
        EpiSplitBf16<0, 0> E{(bf16*)(ws + WS_Y1), (bf16*)(ws + WS_Y1), 1024, 1 << 30, 1.0f / 32.0f, 1.0f / 32.0f};
        pg8::gemm_phase<EpiSplitBf16<0, 0>, pg8::DenseOrder8, true, true>(lds, pg8::Gemm{512, 512, 512}, S, E);
    } SEAM(12);
    if (IN(13)) { p13_mid(in, ws, args.out, lds, vcu, G); } SEAM(13);
    if (IN(14)) {
        { pg8::DenseOrder SR; SR.init(ws + WS_H2, ws + WS_WRT_T, NTOK, 256, 1024, 1024, G, cid);
          EpiF32 E{(float*)(ws + WS_LOGITS), 64, 64};
          pg8::gemm_phase<EpiF32, pg8::DenseOrder, true, true>(lds, pg8::Gemm{1024, 1024, 1024}, SR, E); }
        asm volatile("s_waitcnt vmcnt(0)" ::: "memory"); __syncthreads();
        { int tid2 = threadIdx.x; asm volatile("" : "+v"(tid2)); const int lane2 = tid2 & 63, wave2 = __builtin_amdgcn_readfirstlane(tid2 >> 6);
          LAS unsigned* hist = (LAS unsigned*)lds; if (tid2 < 64) hist[tid2] = 0u; __syncthreads();
          unsigned mycount = 0;
          for (int L = cid; L < NTOK / 256; L += G) {
              const int xcd = L % 8, off = L / 8, wg = xcd * ((NTOK / 256) / 8) + off, pm = (wg / 8) * 8 + (wg % 8);
              route_tile(in, ws, pm * 256, wave2, lane2, mycount); }
          if (mycount) lds_add(&hist[lane2], mycount);
          __syncthreads();
          if (tid2 < 64 && hist[tid2]) atomicAdd((unsigned*)(ws + WS_CTL) + CW_CNT + tid2, hist[tid2]);
          __syncthreads(); }
        { pg8::DenseOrder S;
          if (G == 256) { S.init(ws + WS_H2, ws + WS_WSHGU_T, NTOK, 512, 1024, 1024, 128, cid >= 128 ? cid - 128 : 0); if (cid < 128) S.nwg = 0; }
          else S.init(ws + WS_H2, ws + WS_WSHGU_T, NTOK, 512, 1024, 1024, G, cid);
          EpiGlu E{(bf16*)(ws + WS_ACTSH), 1.0f};
          pg8::gemm_phase<EpiGlu, pg8::DenseOrder, true, true>(lds, pg8::Gemm{1024, 1024, 1024}, S, E); }
    } SEAM(14);
    if (IN(15)) {
        p16_fill(ws, lds, vcu, G);
        pg8::DenseOrder S; S.init(ws + WS_ACTSH, ws + WS_WSHD_T, NTOK, 1024, 256, 256, G, cid);
        EpiF8W E{ws + WS_Y2, 1024, 8.0f};
        pg8::gemm_phase<EpiF8W, pg8::DenseOrder, true, true>(lds, pg8::Gemm{256, 256, 256}, S, E);
    } SEAM(15);
    if (IN(17)) {
        const int ntiles = (int)((const unsigned*)(ws + WS_CTL))[CW_NT];
        MoeOrder<true, true> S{(const int*)(ws + WS_TILEE), (const int*)(ws + WS_LISTTOK), ntiles * 2, 2, 0, G, cid, (const char*)(ws + WS_H2F8), (const char*)(ws + WS_WEGU8), 0, (size_t)512 * 1024, (size_t)256 * 1024};
        EpiGlu8 E{(unsigned char*)(ws + WS_ACT8), 1.0f / 32.0f};
        pg8::gemm_phase<EpiGlu8, MoeOrder<true, true>, true, true>(lds, pg8::Gemm{512, 512, 512}, S, E);
    } SEAM(17);
    if (IN(18)) {
        const int ntiles = (int)((const unsigned*)(ws + WS_CTL))[CW_NT];
        MoeOrder<false, true> S{(const int*)(ws + WS_TILEE), (const int*)(ws + WS_LISTTOK), ntiles * 4, 4, 0, G, cid, (const char*)(ws + WS_ACT8), (const char*)(ws + WS_WED8), (size_t)256 * 256, (size_t)1024 * 256, (size_t)256 * 256};
        EpiSlot E{ws, (const int*)(ws + WS_LISTP), (const float*)(ws + WS_LISTW), 8.0f / 32.0f};
        pg8::gemm_phase<EpiSlot, MoeOrder<false, true>, true, true>(lds, pg8::Gemm{128, 128, 128}, S, E);
    } SEAM(18);
    if (IN(19)) { p19_final(in, ws, args.out, vcu, G); }
#undef IN
#undef SEAM
}

extern "C" void kernel_launch(void* const* d_in, const int* in_sizes, int n_in, void* d_out, int out_size, void* d_ws, size_t ws_size, hipStream_t stream) {
    static int grid = 0;
    if (grid == 0) {
        if (n_in != 25 || in_sizes[0] != NTOK * DM || out_size != NTOK * DM || ws_size < WS_NEED) { fprintf(stderr, "kernel_launch: unexpected shapes / workspace (%d inputs, ws %zu); nothing launched\n", n_in, ws_size); grid = -1; return; }
        int dev = 0, cus = 0;
        if (hipGetDevice(&dev) != hipSuccess || hipDeviceGetAttribute(&cus, hipDeviceAttributeMultiprocessorCount, dev) != hipSuccess) { grid = -1; return; }
        if (hipFuncSetAttribute((const void*)mk_fwd, hipFuncAttributeMaxDynamicSharedMemorySize, LDS_BYTES) != hipSuccess) { grid = -1; return; }
        int per_cu = 0;
        if (hipOccupancyMaxActiveBlocksPerMultiprocessor(&per_cu, (const void*)mk_fwd, NTHR, LDS_BYTES) != hipSuccess || per_cu < 1) { fprintf(stderr, "kernel_launch: occupancy query says %d\n", per_cu); (void)hipGetLastError(); }
        grid = cus > 256 ? 256 : cus;
    }
    if (grid < 0) return;
    (void)hipMemsetAsync((char*)d_ws + WS_CTL, 0, CTL_ZERO_BYTES, stream);
    Args a{};
    const float** ip = (const float**)&a.in;
    for (int i = 0; i < 25; ++i) ip[i] = (const float*)d_in[i];
    a.out = (float*)d_out; a.ws = (unsigned char*)d_ws;
    a.ph_lo = 0; a.ph_hi = N_PHASES;
    hipLaunchKernelGGL(mk_fwd, dim3(grid), dim3(NTHR), LDS_BYTES, stream, a);
}
```
